# Optimizing an MI355X kernel written in HIP

```python
import math
import jax
import jax.numpy as jnp
from jax import lax
import numpy as np

D_MODEL = 1024
BATCH = 16
SEQ = 256
DEPTH = 4
DEC_BATCH = 4
DEC_SEQ = 2048
PAST_LEN = 256

F32 = jnp.float32
GRID_W = 64
N_AB = (DEPTH + 1) // 2
N_C = DEPTH // 2
GLA_W = D_MODEL // 2
GLA_HEADS = 4
GLA_DV = GLA_W // GLA_HEADS
GLA_DK = GLA_DV // 2
GLA_QK = GLA_HEADS * GLA_DK
GLA_LORA = 16
GLA_NORMALIZER = 16.0
GLA_CHUNK = 64
GLA_COLS = 2 * GLA_QK + 2 * GLA_W + 2 * GLA_LORA
GLA_SPLITS = [GLA_QK, 2 * GLA_QK, 2 * GLA_QK + GLA_W, 2 * GLA_QK + 2 * GLA_W]
RWKV_W = D_MODEL - GLA_W
RWKV_N = 64
RWKV_HEADS = RWKV_W // RWKV_N
DECAY_LORA = 64
A_LORA = 64
G_LORA = 160
RWKV_COLS = 3 * RWKV_W + 2 * DECAY_LORA + 2 * A_LORA + G_LORA
RWKV_SPLITS = [RWKV_W, 2 * RWKV_W, 3 * RWKV_W, 3 * RWKV_W + 2 * DECAY_LORA, 3 * RWKV_W + 2 * DECAY_LORA + 2 * A_LORA]
AB_IN = GLA_COLS + RWKV_COLS
HY_W = D_MODEL
HY_EMB = 33
HY_BANDS = (HY_EMB - 1) // 2
HY_FO = 64
HY_TARGET = 1e-2
HY_FAST = 0.3
HY_SLOW = 1.5
D_FF = ((8 * D_MODEL // 3 + 255) // 256) * 256
ALPHA = (2 * DEPTH) ** 0.25
BETA = (8 * DEPTH) ** -0.25
LN_EPS = 1e-5
GN_EPS = 64e-5

kernel_name = 'hybrid_gla_rwkv7_hyena_diffusion_step'


def layer_norm(x, g, b):
    xf = x.astype(F32)
    mu = xf.mean(-1, keepdims=True)
    var = jnp.square(xf - mu).mean(-1, keepdims=True)
    return ((xf - mu) * lax.rsqrt(var + LN_EPS) * g + b).astype(x.dtype)


def prev_tok(x):
    return jnp.pad(x, ((0, 0), (1, 0), (0, 0)))[:, :-1]


def next_tok(x):
    return jnp.pad(x, ((0, 0), (0, 1), (0, 0)))[:, 1:]


def flip(t):
    return jnp.flip(t, axis=1)


def grid_pos_embed(n_tok):
    rows = n_tok // GRID_W
    idx = jnp.arange(rows * GRID_W)
    quarter = D_MODEL // 4
    omega = 1.0 / (10000.0 ** (jnp.arange(quarter, dtype=F32) / quarter))

    def sincos(pos):
        ang = pos.astype(F32)[:, None] * omega[None, :]
        return jnp.concatenate([jnp.sin(ang), jnp.cos(ang)], -1)

    return jnp.concatenate([sincos(idx // GRID_W), sincos(idx % GRID_W)], -1)


def gla_chunked(q, k, v, log_a, s0):
    bsz, n_tok, nh, _ = q.shape
    dv = v.shape[-1]
    n = n_tok // GLA_CHUNK

    def chunks(t):
        return t.astype(F32).reshape(bsz, n, GLA_CHUNK, nh, t.shape[-1])

    q, k, v, log_a = chunks(q), chunks(k), chunks(v), chunks(log_a)
    cum = jnp.cumsum(log_a, axis=2)
    last = cum[:, :, -1:]
    q_in = q * jnp.exp(cum)
    k_in = k * jnp.exp(-cum)
    k_out = k * jnp.exp(last - cum)
    mask = jnp.tril(jnp.ones((GLA_CHUNK, GLA_CHUNK), dtype=bool))
    scores = jnp.where(mask, jnp.einsum('bnchk,bnshk->bnhcs', q_in, k_in), 0.0)
    o_intra = jnp.einsum('bnhcs,bnshv->bnchv', scores, v)
    kv = jnp.einsum('bnchk,bnchv->bnhkv', k_out, v)
    dec = jnp.exp(last[:, :, 0])

    def step(s, inp):
        d, kv_n = inp
        return d[..., None] * s + kv_n, s

    s_fin, s_start = lax.scan(step, s0.astype(F32), (jnp.moveaxis(dec, 1, 0), jnp.moveaxis(kv, 1, 0)))
    o_inter = jnp.einsum('bnchk,nbhkv->bnchv', q_in, s_start)
    return (o_intra + o_inter).reshape(bsz, n_tok, nh, dv), s_fin


def rwkv7_scan(r, w, k, v, kk, a, s0):
    def step(s, inp):
        r_t, w_t, k_t, v_t, kk_t, a_t = inp
        sa = jnp.einsum('bhij,bhj->bhi', s, -kk_t)
        s = (s * w_t[:, :, None, :] + sa[..., None] * (kk_t * a_t)[:, :, None, :]
             + v_t[..., None] * k_t[:, :, None, :])
        return s, jnp.einsum('bhij,bhj->bhi', s, r_t)

    xs = tuple(jnp.moveaxis(t.astype(F32), 1, 0) for t in (r, w, k, v, kk, a))
    s_fin, ys = lax.scan(step, s0.astype(F32), xs)
    return jnp.moveaxis(ys, 0, 1), s_fin


def gla_mix(u, p, s0):
    bsz, n_tok, _ = u.shape
    q, k, v, g, lr = jnp.split(u, GLA_SPLITS, axis=-1)
    lr = lr.reshape(bsz, n_tok, 2, GLA_LORA)
    log_a = jax.nn.log_sigmoid((jnp.einsum('bldr,drk->bldk', lr, p['gla_w_decay'])
                                + p['gla_b_decay']).astype(F32)) / GLA_NORMALIZER
    log_a = log_a.reshape(bsz, n_tok, 2, GLA_HEADS, GLA_DK)
    q = q.reshape(bsz, n_tok, GLA_HEADS, GLA_DK) * (GLA_DK ** -0.5)
    k = k.reshape(bsz, n_tok, GLA_HEADS, GLA_DK)
    v = v.reshape(bsz, n_tok, GLA_HEADS, GLA_DV)
    o_f, s_f = gla_chunked(q, k, v, log_a[:, :, 0], s0[:, 0])
    o_b, s_b = gla_chunked(flip(q), flip(k), flip(v), flip(log_a[:, :, 1]), s0[:, 1])
    o = o_f + flip(o_b)
    o = o * lax.rsqrt(jnp.square(o).mean(-1, keepdims=True) + LN_EPS) * p['gla_norm_w']
    o = o * jax.nn.silu(g.astype(F32).reshape(bsz, n_tok, GLA_HEADS, GLA_DV))
    return o.reshape(bsz, n_tok, GLA_W), jnp.stack([s_f, s_b], axis=1)


def rwkv_mix(u, p, s0):
    bsz, n_tok, _ = u.shape
    mu = p['rwkv_shift_mu']
    u = u + mu[0] * (prev_tok(u) - u) + mu[1] * (next_tok(u) - u)
    r, k, v, wl, al, gl = jnp.split(u, RWKV_SPLITS, axis=-1)
    wl = jnp.tanh(wl.reshape(bsz, n_tok, 2, DECAY_LORA))
    al = al.reshape(bsz, n_tok, 2, A_LORA)
    w_log = -jax.nn.softplus(-(p['rwkv_w0'] + jnp.einsum('bldr,drc->bldc', wl, p['rwkv_w2'])).astype(F32)) - 0.5
    decay = jnp.exp(-jnp.exp(w_log))
    a = jax.nn.sigmoid((p['rwkv_a0'] + jnp.einsum('bldr,drc->bldc', al, p['rwkv_a2'])).astype(F32))
    g = jax.nn.sigmoid(gl) @ p['rwkv_g2']

    def hd(t):
        return t.reshape(bsz, n_tok, RWKV_HEADS, RWKV_N)

    kk = hd(k * p['rwkv_k_k']).astype(F32)
    kk = kk / jnp.maximum(jnp.sqrt(jnp.sum(jnp.square(kk), -1, keepdims=True)), 1e-12)
    k_dir = k[:, :, None, :].astype(F32) * (1.0 + (a - 1.0) * p['rwkv_k_a'])
    rh, vh = hd(r), hd(v)
    o_f, s_f = rwkv7_scan(rh, hd(decay[:, :, 0]), hd(k_dir[:, :, 0]), vh, kk, hd(a[:, :, 0]), s0[:, 0])
    o_b, s_b = rwkv7_scan(flip(rh), flip(hd(decay[:, :, 1])), flip(hd(k_dir[:, :, 1])), flip(vh), flip(kk),
                          flip(hd(a[:, :, 1])), s0[:, 1])
    o = o_f + flip(o_b)
    mean = o.mean(-1, keepdims=True)
    var = jnp.square(o - mean).mean(-1, keepdims=True)
    o = ((o - mean) * lax.rsqrt(var + GN_EPS)).reshape(bsz, n_tok, RWKV_W) * p['rwkv_ln_w'] + p['rwkv_ln_b']
    bonus = jnp.sum(rh * hd(k) * p['rwkv_r_k'], -1, keepdims=True) * vh
    o = (o + bonus.reshape(bsz, n_tok, RWKV_W)) * g
    return o, jnp.stack([s_f, s_b], axis=1)


def ab_mix(h, p, s0_gla, s0_rwkv):
    u = h @ p['ab_w_in']
    o_gla, s_gla = gla_mix(u[..., :GLA_COLS], p, s0_gla)
    o_rw, s_rw = rwkv_mix(u[..., GLA_COLS:], p, s0_rwkv)
    out = jnp.concatenate([o_gla, o_rw.astype(F32)], -1).astype(h.dtype) @ p['ab_w_out']
    return out, (s_gla, s_rw)


def hyena_filter(n_tok, p):
    t = jnp.linspace(0.0, 1.0, n_tok, dtype=F32)[:, None]
    w = 2.0 * math.pi * jnp.arange(n_tok, dtype=F32)[:, None] / n_tok
    f = jnp.linspace(1e-4, HY_BANDS - 1, HY_BANDS, dtype=F32)[None, :]
    z = jnp.concatenate([t, jnp.cos(f * w), -jnp.sin(f * w)], -1)
    fr = p['hy_f_freq']
    hh = jnp.sin(fr[0] * (z @ p['hy_f_w1'] + p['hy_f_b1']))
    hh = jnp.sin(fr[1] * (hh @ p['hy_f_w2'] + p['hy_f_b2']))
    hh = jnp.sin(fr[2] * (hh @ p['hy_f_w3'] + p['hy_f_b3']))
    hh = (hh @ p['hy_f_w4']).astype(F32).reshape(n_tok, 2, HY_W)
    max_decay = math.log(HY_TARGET) / HY_FAST
    min_decay = math.log(HY_TARGET) / HY_SLOW
    deltas = jnp.abs(jnp.linspace(min_decay, max_decay, HY_W, dtype=F32))
    hh = hh * jnp.exp(-t * deltas[None, :])[:, None, :]
    return hh[:, 0], hh[:, 1]


def bidir_fftconv(u, h_fwd, h_bwd):
    n_tok = u.shape[1]
    filt = jnp.concatenate([h_fwd, jnp.zeros((1, h_fwd.shape[1]), F32), jnp.flip(h_bwd[1:], 0)], 0)
    spec = jnp.fft.rfft(u.astype(F32), n=2 * n_tok, axis=1) * jnp.fft.rfft(filt, n=2 * n_tok, axis=0)[None]
    return jnp.fft.irfft(spec, n=2 * n_tok, axis=1)[:, :n_tok]


def hyena_mix(h, p):
    n_tok = h.shape[1]
    u = h @ p['hy_w_in']
    cw = p['hy_conv_w']
    u = prev_tok(u) * cw[0] + u * cw[1] + next_tok(u) * cw[2] + p['hy_conv_b']
    x0, x1, v = jnp.split(u.astype(F32), 3, axis=-1)
    h_fwd, h_bwd = hyena_filter(n_tok, p)
    v = v * x1
    y = bidir_fftconv(v, h_fwd, h_bwd) + v * p['hy_bias']
    return (y * x0).astype(h.dtype) @ p['hy_w_out']


def swiglu(h, lp):
    return (jax.nn.silu(h @ lp['w_gate']) * (h @ lp['w_up'])) @ lp['w_down']


def sublayers(x, cond, lp, mixer):
    mod = jnp.einsum('bd,de->be', jax.nn.silu(cond), lp['w_mod']) + lp['b_mod']
    sh1, sc1, g1, sh2, sc2, g2 = jnp.split(mod[:, None, :], 6, axis=-1)
    m, aux = mixer(x * (1.0 + sc1) + sh1)
    x = layer_norm(ALPHA * x + g1 * m, lp['ln_g'][0], lp['ln_b'][0])
    f = swiglu(x * (1.0 + sc2) + sh2, lp)
    x = layer_norm(ALPHA * x + g2 * f, lp['ln_g'][1], lp['ln_b'][1])
    return x, aux


def setup_inputs(seed: int = 0) -> dict:
    key = jax.random.key(seed)
    ks = iter(jax.random.split(key, 64))

    def nrm(shape, scale):
        return scale * jax.random.normal(next(ks), shape, F32)

    def unif(shape, lo, hi):
        return jax.random.uniform(next(ks), shape, F32, lo, hi)

    D = D_MODEL
    return {
        'x_prompt': nrm((BATCH, SEQ, D), 1.0),
        'x_sample': nrm((DEC_BATCH, DEC_SEQ, D), 1.0),
        'state_gla': nrm((DEC_BATCH, N_AB, 2, GLA_HEADS, GLA_DK, GLA_DV), 1.0),
        'state_rwkv': nrm((DEC_BATCH, N_AB, 2, RWKV_HEADS, RWKV_N, RWKV_N), 1.0),
        'c': nrm((DEC_BATCH, D), 1.0),
        'c_ctx': nrm((D,), 1.0),
        'w_mod': nrm((DEPTH, D, 6 * D), 0.5 * D ** -0.5),
        'b_mod': nrm((DEPTH, 6 * D), 0.02),
        'ln_g': 1.0 + nrm((DEPTH, 2, D), 0.02),
        'ln_b': nrm((DEPTH, 2, D), 0.02),
        'ffn_w_gate': nrm((DEPTH, D, D_FF), D ** -0.5),
        'ffn_w_up': nrm((DEPTH, D, D_FF), D ** -0.5),
        'ffn_w_down': nrm((DEPTH, D_FF, D), BETA * D_FF ** -0.5),
        'ab_w_in': nrm((N_AB, D, AB_IN), D ** -0.5),
        'ab_w_out': nrm((N_AB, D, D), BETA * D ** -0.5),
        'gla_w_decay': nrm((N_AB, 2, GLA_LORA, GLA_QK), GLA_LORA ** -0.5),
        'gla_b_decay': nrm((N_AB, 2, GLA_QK), 0.1),
        'gla_norm_w': 1.0 + nrm((N_AB, GLA_DV), 0.02),
        'rwkv_shift_mu': unif((N_AB, 2, RWKV_COLS), 0.0, 0.5),
        'rwkv_w0': unif((N_AB, 2, RWKV_W), -6.0, 1.0),
        'rwkv_w2': nrm((N_AB, 2, DECAY_LORA, RWKV_W), 0.5 * DECAY_LORA ** -0.5),
        'rwkv_a0': nrm((N_AB, 2, RWKV_W), 0.1),
        'rwkv_a2': nrm((N_AB, 2, A_LORA, RWKV_W), 0.5 * A_LORA ** -0.5),
        'rwkv_g2': nrm((N_AB, G_LORA, RWKV_W), G_LORA ** -0.5),
        'rwkv_k_k': 0.85 + nrm((N_AB, RWKV_W), 0.05),
        'rwkv_k_a': 1.0 + nrm((N_AB, RWKV_W), 0.05),
        'rwkv_r_k': nrm((N_AB, RWKV_HEADS, RWKV_N), 0.1),
        'rwkv_ln_w': 1.0 + nrm((N_AB, RWKV_W), 0.02),
        'rwkv_ln_b': nrm((N_AB, RWKV_W), 0.02),
        'hy_w_in': nrm((N_C, D, 3 * HY_W), D ** -0.5),
        'hy_conv_w': nrm((N_C, 3, 3 * HY_W), 3 ** -0.5),
        'hy_conv_b': nrm((N_C, 3 * HY_W), 0.02),
        'hy_f_w1': nrm((N_C, HY_EMB, HY_FO), HY_EMB ** -0.5),
        'hy_f_b1': nrm((N_C, HY_FO), 0.1),
        'hy_f_w2': nrm((N_C, HY_FO, HY_FO), HY_FO ** -0.5),
        'hy_f_b2': nrm((N_C, HY_FO), 0.1),
        'hy_f_w3': nrm((N_C, HY_FO, HY_FO), HY_FO ** -0.5),
        'hy_f_b3': nrm((N_C, HY_FO), 0.1),
        'hy_f_freq': 1.0 + nrm((N_C, 3, HY_FO), 0.1),
        'hy_f_w4': nrm((N_C, HY_FO, 2 * HY_W), 0.1 * HY_FO ** -0.5),
        'hy_bias': nrm((N_C, HY_W), 0.5),
        'hy_w_out': nrm((N_C, D, D), BETA * D ** -0.5),
    }


def reference(x_prompt, x_sample, state_gla, state_rwkv, c, c_ctx, w_mod, b_mod, ln_g, ln_b,
              ffn_w_gate, ffn_w_up, ffn_w_down, ab_w_in, ab_w_out, gla_w_decay, gla_b_decay, gla_norm_w,
              rwkv_shift_mu, rwkv_w0, rwkv_w2, rwkv_a0, rwkv_a2, rwkv_g2, rwkv_k_k, rwkv_k_a, rwkv_r_k,
              rwkv_ln_w, rwkv_ln_b, hy_w_in, hy_conv_w, hy_conv_b, hy_f_w1, hy_f_b1, hy_f_w2, hy_f_b2,
              hy_f_w3, hy_f_b3, hy_f_freq, hy_f_w4, hy_bias, hy_w_out):
    x_ctx = x_prompt
    x_lat = x_sample + grid_pos_embed(x_sample.shape[1]).astype(x_sample.dtype)
    n_ctx = x_prompt.shape[0]
    cond_ctx = c_ctx[None, :]
    gla_new = []
    rwkv_new = []
    for layer in range(DEPTH):
        lp = {'w_mod': w_mod[layer], 'b_mod': b_mod[layer], 'ln_g': ln_g[layer], 'ln_b': ln_b[layer],
              'w_gate': ffn_w_gate[layer], 'w_up': ffn_w_up[layer], 'w_down': ffn_w_down[layer]}
        i = layer // 2
        if layer % 2 == 0:
            ap = {'ab_w_in': ab_w_in[i], 'ab_w_out': ab_w_out[i], 'gla_w_decay': gla_w_decay[i],
                  'gla_b_decay': gla_b_decay[i], 'gla_norm_w': gla_norm_w[i], 'rwkv_shift_mu': rwkv_shift_mu[i],
                  'rwkv_w0': rwkv_w0[i], 'rwkv_w2': rwkv_w2[i], 'rwkv_a0': rwkv_a0[i], 'rwkv_a2': rwkv_a2[i],
                  'rwkv_g2': rwkv_g2[i], 'rwkv_k_k': rwkv_k_k[i], 'rwkv_k_a': rwkv_k_a[i], 'rwkv_r_k': rwkv_r_k[i],
                  'rwkv_ln_w': rwkv_ln_w[i], 'rwkv_ln_b': rwkv_ln_b[i]}
            zero_gla = jnp.zeros((n_ctx, 2, GLA_HEADS, GLA_DK, GLA_DV), F32)
            zero_rwkv = jnp.zeros((n_ctx, 2, RWKV_HEADS, RWKV_N, RWKV_N), F32)
            x_ctx, (s_gla, s_rwkv) = sublayers(x_ctx, cond_ctx, lp,
                                               lambda h: ab_mix(h, ap, zero_gla, zero_rwkv))
            x_lat, _ = sublayers(x_lat, c, lp,
                                 lambda h: ab_mix(h, ap, state_gla[:, i], state_rwkv[:, i]))
            gla_new.append(s_gla)
            rwkv_new.append(s_rwkv)
        else:
            hp = {'hy_w_in': hy_w_in[i], 'hy_conv_w': hy_conv_w[i], 'hy_conv_b': hy_conv_b[i],
                  'hy_f_w1': hy_f_w1[i], 'hy_f_b1': hy_f_b1[i], 'hy_f_w2': hy_f_w2[i], 'hy_f_b2': hy_f_b2[i],
                  'hy_f_w3': hy_f_w3[i], 'hy_f_b3': hy_f_b3[i], 'hy_f_freq': hy_f_freq[i], 'hy_f_w4': hy_f_w4[i],
                  'hy_bias': hy_bias[i], 'hy_w_out': hy_w_out[i]}
            x_ctx, _ = sublayers(x_ctx, cond_ctx, lp, lambda h: (hyena_mix(h, hp), None))
            x_lat, _ = sublayers(x_lat, c, lp, lambda h: (hyena_mix(h, hp), None))
    new_state_gla = jnp.stack(gla_new, axis=1)
    new_state_rwkv = jnp.stack(rwkv_new, axis=1)
    return (x_ctx, x_lat, new_state_gla, new_state_rwkv)
```

```cpp
#include <hip/hip_runtime.h>
#include <hip/hip_cooperative_groups.h>
#include <cstdio>
#include <cstdint>
namespace cg = cooperative_groups;
#define MK_ONE_LAUNCH 1
namespace pg8 {
#define PG8_LAS __attribute__((address_space(3)))
typedef unsigned short bf16_t;
typedef short bf16x8 __attribute__((ext_vector_type(8)));
typedef float f32x4 __attribute__((ext_vector_type(4)));
typedef unsigned u32x4 __attribute__((ext_vector_type(4)));
constexpr int BM = 256, BK = 64, HALF = 128, HTB = HALF * BK * 2  , STAGE_BYTES = 8 * HTB, NXCD = 8, WGM = 8;

__host__ __device__ __forceinline__ int lds_byte(int r, int c) { const int st = (r >> 4) * 2 + (c >> 5), rr = r & 15, cc = c & 31, ob = rr * 64 + cc * 2; return st * 1024 + (ob ^ (((ob >> 9) & 1) << 5)); }
__host__ __device__ __forceinline__ void stage_rc(int b, int& R, int& C) { const int st = b / 1024, sb = b % 1024, swz = sb ^ (((sb >> 9) & 1) << 5); R = (st >> 1) * 16 + swz / 64; C = (st & 1) * 32 + (swz % 64) / 2; }
__host__ __device__ __forceinline__ int perm32(int rho) { const int n = rho >> 4, i = rho & 15; return 8 * (i >> 2) + 4 * n + (i & 3); }

struct Unit { int pm, pn; };
struct Gemm { const bf16_t* A; const bf16_t* Bt; int M, N, K; };

struct StaticOrder {
    int nM, nN, nwg, G, c;
    __host__ __device__ void init(int M, int N, int G_, int c_) { nM = M / BM; nN = N / BM; nwg = nM * nN; G = G_; c = c_; }
    __host__ __device__ bool next(int i, Unit& u) const {
        const long L = (long)i * G + c; if (L >= nwg) return false;
        int wgid = (int)L; { const int q = nwg / NXCD, r = nwg % NXCD, xcd = wgid % NXCD, off = wgid / NXCD; wgid = (xcd < r ? xcd * (q + 1) : r * (q + 1) + (xcd - r) * q) + off; }
        const int nig = WGM * nN, gid = wgid / nig, fm = gid * WGM, gsz = (nM - fm) < WGM ? (nM - fm) : WGM;
        u.pm = fm + ((wgid % nig) % gsz); u.pn = (wgid % nig) / gsz; return true;
    }
    __device__ __forceinline__ void a_ready(const Unit&) const {}
    __device__ __forceinline__ void done(const Unit&) const {}
};

__device__ __forceinline__ unsigned cvt_pk_bf16(float lo, float hi) { unsigned r; asm volatile("v_cvt_pk_bf16_f32 %0, %1, %2" : "=v"(r) : "v"(lo), "v"(hi)); return r; }
typedef unsigned u32x2 __attribute__((ext_vector_type(2)));
struct EpiStoreBf16 {
    static constexpr bool PERM = false, AFTER_DRAIN = false;
    bf16_t* O; int ldc;
    __device__ __forceinline__ void operator()(const f32x4 (&acc)[2][2][4][2], const Unit& u, int wr, int wc, int fr, int fq) const {
        const int row0 = u.pm * BM + wr * 64 + fr, col0 = u.pn * BM + wc * 32 + 4 * fq;
#pragma unroll
        for (int ai = 0; ai < 2; ++ai)
#pragma unroll
            for (int m = 0; m < 4; ++m) { bf16_t* rowp = O + (size_t)(row0 + ai * HALF + m * 16) * ldc + col0;
#pragma unroll
                for (int bj = 0; bj < 2; ++bj)
#pragma unroll
                    for (int n = 0; n < 2; ++n) { const f32x4 v = acc[ai][bj][m][n]; u32x2 w; w.x = cvt_pk_bf16(v[0], v[1]); w.y = cvt_pk_bf16(v[2], v[3]);
                        *(u32x2*)(rowp + bj * HALF + n * 16) = w; } }
    }
};
struct EpiSwiGLU {
    static constexpr bool PERM = false, AFTER_DRAIN = false;
    bf16_t* O; int ldc;
    __device__ __forceinline__ void operator()(const f32x4 (&acc)[2][2][4][2], const Unit& u, int wr, int wc, int fr, int fq) const {
        const int row0 = u.pm * BM + wr * 64 + fr, col0 = u.pn * BM + wc * 32 + 4 * fq;
#pragma unroll
        for (int ai = 0; ai < 2; ++ai)
#pragma unroll
            for (int m = 0; m < 4; ++m) { bf16_t* rowp = O + (size_t)(row0 + ai * HALF + m * 16) * ldc;
#pragma unroll
                for (int bj = 0; bj < 2; ++bj)
#pragma unroll
                    for (int n = 0; n < 2; ++n) { const f32x4 v = acc[ai][bj][m][n];
                        const float a0 = v[0] * __builtin_amdgcn_rcpf(1.f + __expf(-v[0])) * v[1];
                        const float a1 = v[2] * __builtin_amdgcn_rcpf(1.f + __expf(-v[2])) * v[3];
                        *(unsigned*)(rowp + ((col0 + bj * HALF + n * 16) >> 1)) = cvt_pk_bf16(a0, a1); } }
    }
};
struct EpiRes {
    static constexpr bool PERM = false, AFTER_DRAIN = false;
    float* X; const float* gate; float alpha;
    __device__ __forceinline__ void operator()(const f32x4 (&acc)[2][2][4][2], const Unit& u, int wr, int wc, int fr, int fq) const {
        const int row0 = u.pm * BM + wr * 64 + fr, col0 = u.pn * BM + wc * 32 + 4 * fq;
        const int ci = u.pm < 16 ? 0 : 1 + ((u.pm - 16) >> 3);
        const float* gp = gate + ci * 6144 + col0;
        f32x4 gv[2][2];
#pragma unroll
        for (int bj = 0; bj < 2; ++bj)
#pragma unroll
            for (int n = 0; n < 2; ++n) gv[bj][n] = *(const f32x4*)(gp + bj * HALF + n * 16);
#pragma unroll
        for (int ai = 0; ai < 2; ++ai)
#pragma unroll
            for (int m = 0; m < 4; ++m) { float* rowp = X + (size_t)(row0 + ai * HALF + m * 16) * 1024 + col0;
#pragma unroll
                for (int bj = 0; bj < 2; ++bj)
#pragma unroll
                    for (int n = 0; n < 2; ++n) { f32x4* p = (f32x4*)(rowp + bj * HALF + n * 16); const f32x4 xv = *p; *p = xv * alpha + gv[bj][n] * acc[ai][bj][m][n]; } }
    }
};
template <class Epi, class Sched, bool ALIGN_EPI = false, bool SP2 = false>
__device__ __forceinline__ void gemm_phase(PG8_LAS unsigned char* lds, const Gemm g, const Sched& S, const Epi& E) {
    int tid = threadIdx.x; asm volatile("" : "+v"(tid)); const int wid = __builtin_amdgcn_readfirstlane(tid >> 6), lane = tid & 63, wr = wid >> 2, wc = wid & 3, fr = lane & 15, fq = lane >> 4;
    const int K = g.K, nt = K / BK;
    unsigned voffA[2], voffB[2];
#pragma unroll
    for (int i = 0; i < 2; ++i) { int R, C; stage_rc(tid * 16 + i * 8192, R, C); const int Rb = Epi::PERM ? ((R & ~31) + perm32(R & 31)) : R;
        voffA[i] = (unsigned)(R * K + C) * 2u; voffB[i] = (unsigned)(Rb * K + C) * 2u; }
    const size_t kstep = (size_t)(BK * 2);
    const size_t hstep = (size_t)HALF * K * 2;
    const size_t tstep = 2 * hstep;
    const unsigned ldsw = (unsigned)wid * 1024u;
    const int aoff = lds_byte(wr * 64 + fr, fq * 8), boff = lds_byte(wc * 32 + fr, fq * 8);
#define PG8_SA(b, h) (((b) * 2 + (h)) * HTB)
#define PG8_SB(b, h) ((4 + (b) * 2 + (h)) * HTB)
#define PG8_STAGE(bufoff, gbase, voff) do { _Pragma("unroll") for (int _i = 0; _i < 2; ++_i) \
        __builtin_amdgcn_global_load_lds((const unsigned*)((const char*)(gbase) + (voff)[_i]), (PG8_LAS unsigned*)(lds + (bufoff) + ldsw + _i * 8192), 16, 0, 0); } while (0)
#define PG8_LDA(dst, b, h) do { _Pragma("unroll") for (int m = 0; m < 4; ++m) _Pragma("unroll") for (int k = 0; k < 2; ++k) dst[m][k] = *(const PG8_LAS bf16x8*)(lds + PG8_SA(b, h) + aoff + m * 2048 + k * 1024); } while (0)
#define PG8_LDB(dst, b, h) do { _Pragma("unroll") for (int n = 0; n < 2; ++n) _Pragma("unroll") for (int k = 0; k < 2; ++k) dst[n][k] = *(const PG8_LAS bf16x8*)(lds + PG8_SB(b, h) + boff + n * 2048 + k * 1024); } while (0)
#define PG8_MMA(ai, bj, At, Bt) do { __builtin_amdgcn_s_setprio(1); _Pragma("unroll") for (int m = 0; m < 4; ++m) _Pragma("unroll") for (int n = 0; n < 2; ++n) _Pragma("unroll") for (int k = 0; k < 2; ++k) \
        acc[ai][bj][m][n] = __builtin_amdgcn_mfma_f32_16x16x32_bf16(Bt[n][k], At[m][k], acc[ai][bj][m][n], 0, 0, 0); __builtin_amdgcn_s_setprio(0); } while (0)
#define PG8_WAIT_V(n) asm volatile("s_waitcnt vmcnt(" #n ")" ::: "memory")
#define PG8_WAIT_L(n) asm volatile("s_waitcnt lgkmcnt(" #n ")" ::: "memory")
#define PG8_BAR __builtin_amdgcn_s_barrier()
#define PG8_SCHED __builtin_amdgcn_sched_barrier(0)
    Unit cur, nxt; int ui = 0;
    if (!S.next(0, cur)) return;
    f32x4 acc[2][2][4][2];
#pragma unroll
    for (int a = 0; a < 2; ++a)
#pragma unroll
        for (int b = 0; b < 2; ++b)
#pragma unroll
            for (int m = 0; m < 4; ++m)
#pragma unroll
                for (int n = 0; n < 2; ++n) acc[a][b][m][n] = (f32x4){0.f, 0.f, 0.f, 0.f};
    bf16x8 At[4][2], B0[2][2], B1[2][2];
    const char* cA = (const char*)g.A + (size_t)cur.pm * tstep; const char* cB = (const char*)g.Bt + (size_t)cur.pn * tstep;
    S.a_ready(cur);
    if constexpr (SP2) {
        PG8_STAGE(PG8_SB(0, 0), cB, voffB); PG8_STAGE(PG8_SB(0, 1), cB + hstep, voffB); PG8_STAGE(PG8_SA(0, 0), cA, voffA); PG8_STAGE(PG8_SA(0, 1), cA + hstep, voffA);
        if (wr == 1) PG8_BAR;
        PG8_WAIT_V(2); PG8_BAR;
        PG8_STAGE(PG8_SB(1, 0), cB + kstep, voffB); PG8_STAGE(PG8_SA(1, 0), cA + kstep, voffA); PG8_STAGE(PG8_SB(1, 1), cB + hstep + kstep, voffB);
        PG8_WAIT_V(6); PG8_BAR;
    } else {
        PG8_STAGE(PG8_SB(0, 0), cB, voffB); PG8_STAGE(PG8_SA(0, 0), cA, voffA); PG8_STAGE(PG8_SB(0, 1), cB + hstep, voffB); PG8_STAGE(PG8_SA(0, 1), cA + hstep, voffA);
        if (wr == 1) PG8_BAR;
        PG8_WAIT_V(4); PG8_BAR;
        PG8_STAGE(PG8_SB(1, 0), cB + kstep, voffB); PG8_STAGE(PG8_SA(1, 0), cA + kstep, voffA); PG8_STAGE(PG8_SB(1, 1), cB + hstep + kstep, voffB);
        PG8_WAIT_V(6); PG8_BAR;
    }
    for (;;) {
        const bool has_next = S.next(ui + 1, nxt);
        const char* nA = has_next ? (const char*)g.A + (size_t)nxt.pm * tstep : cA; const char* nB = has_next ? (const char*)g.Bt + (size_t)nxt.pn * tstep : cB;
        for (int t = 0; t < nt; t += 2) {
            const bool last = (t == nt - 2);
            const char* a1 = cA + (size_t)(t + 1) * kstep;
            const char* a2 = last ? nA : cA + (size_t)(t + 2) * kstep; const char* b2 = last ? nB : cB + (size_t)(t + 2) * kstep;
            const char* a3 = a2 + kstep; const char* b3 = b2 + kstep;
            if (last && has_next) S.a_ready(nxt);
            if constexpr (SP2) {
            PG8_LDB(B0, 0, 0); PG8_LDB(B1, 0, 1); PG8_SCHED; PG8_LDA(At, 0, 0); PG8_STAGE(PG8_SA(1, 1), a1 + hstep, voffA);
            PG8_WAIT_V(8); PG8_WAIT_L(0); PG8_BAR; PG8_MMA(0, 0, At, B0); PG8_MMA(0, 1, At, B1); PG8_BAR; PG8_SCHED;
            PG8_LDA(At, 0, 1); PG8_STAGE(PG8_SB(0, 0), b2, voffB); PG8_STAGE(PG8_SB(0, 1), b2 + hstep, voffB); PG8_STAGE(PG8_SA(0, 0), a2, voffA);
            PG8_WAIT_V(8); PG8_WAIT_L(0); PG8_BAR; PG8_MMA(1, 0, At, B0); PG8_MMA(1, 1, At, B1); PG8_BAR; PG8_SCHED;
            PG8_LDB(B0, 1, 0); PG8_LDB(B1, 1, 1); PG8_SCHED; PG8_LDA(At, 1, 0); PG8_STAGE(PG8_SA(0, 1), a2 + hstep, voffA);
            PG8_WAIT_V(8); PG8_WAIT_L(0); PG8_BAR; PG8_MMA(0, 0, At, B0); PG8_MMA(0, 1, At, B1); PG8_BAR; PG8_SCHED;
            PG8_LDA(At, 1, 1); PG8_STAGE(PG8_SB(1, 0), b3, voffB); PG8_STAGE(PG8_SB(1, 1), b3 + hstep, voffB); PG8_STAGE(PG8_SA(1, 0), a3, voffA);
            PG8_WAIT_V(8); PG8_WAIT_L(0); PG8_BAR; PG8_MMA(1, 0, At, B0); PG8_MMA(1, 1, At, B1); PG8_BAR; PG8_SCHED;
            } else {
            PG8_LDB(B0, 0, 0); PG8_SCHED; PG8_LDA(At, 0, 0); PG8_STAGE(PG8_SA(1, 1), a1 + hstep, voffA);
            PG8_WAIT_L(8); PG8_BAR; PG8_WAIT_L(0); PG8_MMA(0, 0, At, B0); PG8_BAR; PG8_SCHED;
            PG8_LDB(B1, 0, 1); PG8_STAGE(PG8_SB(0, 0), b2, voffB);
            PG8_BAR; PG8_WAIT_L(0); PG8_MMA(0, 1, At, B1); PG8_BAR;
            PG8_LDA(At, 0, 1); PG8_STAGE(PG8_SA(0, 0), a2, voffA);
            PG8_BAR; PG8_WAIT_L(0); PG8_MMA(1, 0, At, B0); PG8_BAR; PG8_SCHED;
            PG8_STAGE(PG8_SB(0, 1), b2 + hstep, voffB);
            PG8_WAIT_V(6); PG8_BAR; PG8_MMA(1, 1, At, B1); PG8_BAR;
            PG8_LDB(B0, 1, 0); PG8_SCHED; PG8_LDA(At, 1, 0); PG8_STAGE(PG8_SA(0, 1), a2 + hstep, voffA);
            PG8_WAIT_L(8); PG8_BAR; PG8_WAIT_L(0); PG8_MMA(0, 0, At, B0); PG8_BAR; PG8_SCHED;
            PG8_LDB(B1, 1, 1); PG8_STAGE(PG8_SB(1, 0), b3, voffB);
            PG8_BAR; PG8_WAIT_L(0); PG8_MMA(0, 1, At, B1); PG8_BAR;
            PG8_LDA(At, 1, 1); PG8_STAGE(PG8_SA(1, 0), a3, voffA);
            PG8_BAR; PG8_WAIT_L(0); PG8_MMA(1, 0, At, B0); PG8_BAR; PG8_SCHED;
            PG8_STAGE(PG8_SB(1, 1), b3 + hstep, voffB);
            PG8_WAIT_V(6); PG8_BAR; PG8_MMA(1, 1, At, B1); PG8_BAR;
            }
        }
        if constexpr (ALIGN_EPI) { if (wr == 0) PG8_BAR; }
        if constexpr (!Epi::AFTER_DRAIN) { E(acc, cur, wr, wc, fr, fq); S.done(cur); }
        if (!has_next) break;
#pragma unroll
        for (int a = 0; a < 2; ++a)
#pragma unroll
            for (int b = 0; b < 2; ++b)
#pragma unroll
                for (int m = 0; m < 4; ++m)
#pragma unroll
                    for (int n = 0; n < 2; ++n) acc[a][b][m][n] = (f32x4){0.f, 0.f, 0.f, 0.f};
        cur = nxt; cA = nA; cB = nB; ++ui;
        if constexpr (ALIGN_EPI) { if (wr == 1) PG8_BAR; }
    }
    PG8_WAIT_V(0);
    if constexpr (!ALIGN_EPI) { if (wr == 0) PG8_BAR; }
    PG8_BAR;
    if constexpr (Epi::AFTER_DRAIN) { E.fused(acc, cur, wr, wc, fr, fq, lds, wid, lane); S.done(cur); }
#undef PG8_SA
#undef PG8_SB
#undef PG8_STAGE
#undef PG8_LDA
#undef PG8_LDB
#undef PG8_MMA
#undef PG8_WAIT_V
#undef PG8_WAIT_L
#undef PG8_BAR
#undef PG8_SCHED
}
}
#define DEVI __device__ __forceinline__
typedef unsigned short bf16;
typedef float f32x4 __attribute__((ext_vector_type(4)));
typedef short bf16x8 __attribute__((ext_vector_type(8)));
typedef unsigned u32x4 __attribute__((ext_vector_type(4)));
typedef unsigned u32x2 __attribute__((ext_vector_type(2)));

constexpr int NTOK = 12288, UP = 3584, LOP = 2560, FFP = 2816, HP = 3072;
constexpr size_t MiB = 1u << 20;
constexpr size_t WS_MOD = 0, WS_H3 = 1 * MiB, WS_WMIX = 3 * MiB, WS_WFFN = 15 * MiB, WS_HR = 32 * MiB, WS_A = 50 * MiB, WS_U = 74 * MiB,
                 WS_LO = 158 * MiB, WS_Y = 218 * MiB, WS_KV = 266 * MiB, WS_DEC = 314 * MiB, WS_END = 315 * MiB;
constexpr size_t WS_VGT = WS_LO, WS_X0C = WS_LO + 24 * MiB, WS_YT = WS_Y, WS_X = WS_Y;
constexpr int OUT_SG = 12582912, OUT_SR = 14680064;
constexpr int LDS_BYTES = 139264;
constexpr float ALPHA_F = 1.6817928305074290f;
constexpr float INV2PI = 0.15915494309189535f;

struct Args { const float* in[42]; float* out; unsigned char* ws; int ph_lo, ph_hi; };
typedef const __attribute__((address_space(4))) Args* ArgsP;

DEVI float bflo(unsigned u) { return __uint_as_float(u << 16); }
DEVI float bfhi(unsigned u) { return __uint_as_float(u & 0xffff0000u); }
DEVI unsigned pk2(float lo, float hi) { return pg8::cvt_pk_bf16(lo, hi); }
DEVI float sigm(float x) { return 1.f / (1.f + __expf(-x)); }
DEVI float sin_rev(float rev) { rev -= rintf(rev); return __builtin_amdgcn_sinf(rev); }
DEVI float cos_rev(float rev) { rev -= rintf(rev); return __builtin_amdgcn_cosf(rev); }
DEVI float wave_sum(float v) {
#pragma unroll
    for (int o = 1; o < 64; o <<= 1) v += __shfl_xor(v, o);
    return v;
}
template <int CTRL> DEVI float dppf(float v) { return __int_as_float(__builtin_amdgcn_update_dpp(0, __float_as_int(v), CTRL, 0xf, 0xf, true)); }
DEVI float red8(float v) { v += dppf<0xB1>(v); v += dppf<0x4E>(v); v += dppf<0x141>(v); return v; }
DEVI float red16(float v) { v = red8(v); v += dppf<0x140>(v); return v; }
#define LDSW() asm volatile("s_waitcnt lgkmcnt(0)" ::: "memory")
DEVI void unpack8(const u32x4 w, float* f) { f[0] = bflo(w.x); f[1] = bfhi(w.x); f[2] = bflo(w.y); f[3] = bfhi(w.y); f[4] = bflo(w.z); f[5] = bfhi(w.z); f[6] = bflo(w.w); f[7] = bfhi(w.w); }
DEVI u32x4 pack8(const float* f) { u32x4 w; w.x = pk2(f[0], f[1]); w.y = pk2(f[2], f[3]); w.z = pk2(f[4], f[5]); w.w = pk2(f[6], f[7]); return w; }
DEVI f32x4 mfma16(bf16x8 bfr, bf16x8 afr, f32x4 c) { return __builtin_amdgcn_mfma_f32_16x16x32_bf16(bfr, afr, c, 0, 0, 0); }

DEVI void tokinfo(int tok, int& tok0, int& L) { if (tok < 4096) { tok0 = tok & ~255; L = 256; } else { tok0 = 4096 + ((tok - 4096) & ~2047); L = 2048; } }
DEVI int cond_of(int tok) { return tok < 4096 ? 0 : 1 + ((tok - 4096) >> 11); }

DEVI void tr_item(const float* W, int K, int N, bf16* WT, int row_off, int rmul, float* scr, int item, int lane) {
    const int nblk = N / 32, kb = item / nblk, nb = item % nblk, k0 = 64 * kb, n0 = 32 * nb;
#pragma unroll 8
    for (int i = 0; i < 32; ++i) { const int kk = 2 * i + (lane >> 5); scr[kk * 33 + (lane & 31)] = W[(size_t)(k0 + kk) * N + n0 + (lane & 31)]; }
    LDSW();
    const int c = lane & 7;
#pragma unroll
    for (int j = 0; j < 4; ++j) { const int n = (lane >> 3) + 8 * j; const float* s = scr + (8 * c) * 33 + n;
        u32x4 o; o.x = pk2(s[0 * 33], s[1 * 33]); o.y = pk2(s[2 * 33], s[3 * 33]); o.z = pk2(s[4 * 33], s[5 * 33]); o.w = pk2(s[6 * 33], s[7 * 33]);
        *(u32x4*)(WT + (size_t)(row_off + rmul * (n0 + n)) * K + k0 + 8 * c) = o; }
    LDSW();
}
DEVI void conv_job(const float* W, int K, int N, bf16* WT, int row_off, int rmul, float* scr, int gw, int NGW, int lane, int& rot) {
    const int nitems = (K / 64) * (N / 32); const int start = (gw - (rot % NGW) + NGW) % NGW;
    for (int it = start; it < nitems; it += NGW) tr_item(W, K, N, WT, row_off, rmul, scr, it, lane);
    rot += nitems;
}
DEVI void convert_mix(ArgsP a, int layer, float* scr, int gw, int NGW, int lane) {
    const int i = layer >> 1; int rot = 0;
    bf16* W0 = (bf16*)(a->ws + WS_WMIX); bf16* W1 = (bf16*)(a->ws + WS_WMIX + 7 * MiB); bf16* W2 = (bf16*)(a->ws + WS_WMIX + 9 * MiB);
    if ((layer & 1) == 0) {
        conv_job(a->in[13] + (size_t)i * 1024 * 3520, 1024, 3520, W0, 0, 1, scr, gw, NGW, lane, rot);
        conv_job(a->in[14] + (size_t)i * 1024 * 1024, 1024, 1024, W1, 0, 1, scr, gw, NGW, lane, rot);
        const int gt = gw * 64 + lane, NGT = NGW * 64;
        for (int u = gt; u < 64 * 1024 / 8; u += NGT) *(u32x4*)(W0 + (size_t)3520 * 1024 + (size_t)u * 8) = (u32x4){0u, 0u, 0u, 0u};
        const float* w2 = a->in[20] + (size_t)i * 2 * 64 * 512; const float* a2 = a->in[22] + (size_t)i * 2 * 64 * 512; const float* g2 = a->in[23] + (size_t)i * 160 * 512;
        for (int u = gt; u < 2560 * 64; u += NGT) {
            const int n = u >> 6, k8 = (u & 63) * 8, blk = n >> 9, c = n & 511; float f[8];
#pragma unroll
            for (int e = 0; e < 8; ++e) { const int k = k8 + e; float v = 0.f;
                if (blk < 2) { const int r = k - blk * 64; if (r >= 0 && r < 64) v = w2[(size_t)(blk * 64 + r) * 512 + c]; }
                else if (blk < 4) { const int r = k - 128 - (blk - 2) * 64; if (r >= 0 && r < 64) v = a2[(size_t)((blk - 2) * 64 + r) * 512 + c]; }
                else { const int r = k - 256; if (r >= 0 && r < 160) v = g2[(size_t)r * 512 + c]; }
                f[e] = v; }
            *(u32x4*)(W2 + (size_t)n * 512 + k8) = pack8(f);
        }
    } else {
        conv_job(a->in[29] + (size_t)i * 1024 * 3072, 1024, 3072, W0, 0, 1, scr, gw, NGW, lane, rot);
        conv_job(a->in[41] + (size_t)i * 1024 * 1024, 1024, 1024, W1, 0, 1, scr, gw, NGW, lane, rot);
    }
}
DEVI void convert_ffn(ArgsP a, int layer, float* scr, int gw, int NGW, int lane) {
    int rot = 0; bf16* WGU = (bf16*)(a->ws + WS_WFFN); bf16* WDN = (bf16*)(a->ws + WS_WFFN + 11 * MiB);
    conv_job(a->in[10] + (size_t)layer * 1024 * 2816, 1024, 2816, WGU, 0, 2, scr, gw, NGW, lane, rot);
    conv_job(a->in[11] + (size_t)layer * 1024 * 2816, 1024, 2816, WGU, 1, 2, scr, gw, NGW, lane, rot);
    conv_job(a->in[12] + (size_t)layer * 2816 * 1024, 2816, 1024, WDN, 0, 1, scr, gw, NGW, lane, rot);
}

DEVI void ln_mod_rows(ArgsP a, int mode, const float* lng, const float* lnb, const float* modsh, int gw, int NGW, int lane) {
    float* X = a->out; bf16* A = (bf16*)(a->ws + WS_A);
    for (int row = gw; row < NTOK; row += NGW) {
        f32x4 v[4];
        if (mode == 0) {
            const float* src = row < 4096 ? a->in[0] + (size_t)row * 1024 : a->in[1] + (size_t)(row - 4096) * 1024;
#pragma unroll
            for (int j = 0; j < 4; ++j) v[j] = ((const f32x4*)src)[lane + 64 * j];
            if (row >= 4096) { const int t = (row - 4096) & 2047; const float pr = (float)(t >> 6), pc = (float)(t & 63);
#pragma unroll
                for (int e = 0; e < 4; ++e) { const float om = exp2f(-(float)(4 * lane + e) * (13.287712379549449f / 256.f)) * INV2PI;
                    v[0][e] += sin_rev(pr * om); v[1][e] += cos_rev(pr * om); v[2][e] += sin_rev(pc * om); v[3][e] += cos_rev(pc * om); } }
        } else {
            const float* src = X + (size_t)row * 1024; float s = 0.f;
#pragma unroll
            for (int j = 0; j < 4; ++j) { v[j] = ((const f32x4*)src)[lane + 64 * j]; s += (v[j][0] + v[j][1]) + (v[j][2] + v[j][3]); }
            const float mean = wave_sum(s) * (1.f / 1024.f); float q = 0.f;
#pragma unroll
            for (int j = 0; j < 4; ++j) { v[j] = v[j] - mean; q += (v[j][0] * v[j][0] + v[j][1] * v[j][1]) + (v[j][2] * v[j][2] + v[j][3] * v[j][3]); }
            const float rstd = 1.f / sqrtf(wave_sum(q) * (1.f / 1024.f) + 1e-5f);
#pragma unroll
            for (int j = 0; j < 4; ++j) { const f32x4 g = ((const f32x4*)lng)[lane + 64 * j], b = ((const f32x4*)lnb)[lane + 64 * j]; v[j] = v[j] * rstd * g + b; }
        }
#pragma unroll
        for (int j = 0; j < 4; ++j) ((f32x4*)(X + (size_t)row * 1024))[lane + 64 * j] = v[j];
        if (modsh) { const float* sh = modsh + cond_of(row) * 6144; const float* sc = sh + 1024;
#pragma unroll
            for (int j = 0; j < 4; ++j) { const f32x4 s4 = ((const f32x4*)sh)[lane + 64 * j], c4 = ((const f32x4*)sc)[lane + 64 * j]; const f32x4 o = v[j] * (c4 + 1.f) + s4;
                u32x2 w; w.x = pk2(o[0], o[1]); w.y = pk2(o[2], o[3]); ((u32x2*)(A + (size_t)row * 1024))[lane + 64 * j] = w; } }
    }
}

DEVI void mods_phase(ArgsP a, float* S  , int bid, int nb, int tid) {
    float* MOD = (float*)(a->ws + WS_MOD);
    for (int u = tid; u < 5 * 1024; u += 512) { const int j = u >> 10, d = u & 1023; const float c = j == 0 ? a->in[5][d] : a->in[4][(j - 1) * 1024 + d]; S[u] = c * sigm(c); }
    __syncthreads();
    for (int it = bid; it < 48; it += nb) {
        const int l = it / 12, e = (it % 12) * 512 + tid; const float* w = a->in[6] + (size_t)l * 1024 * 6144 + e;
        float acc[5] = {0.f, 0.f, 0.f, 0.f, 0.f};
#pragma unroll 8
        for (int d = 0; d < 1024; ++d) { const float wv = w[(size_t)d * 6144];
#pragma unroll
            for (int j = 0; j < 5; ++j) acc[j] += S[j * 1024 + d] * wv; }
        const float b = a->in[7][l * 6144 + e];
#pragma unroll
        for (int j = 0; j < 5; ++j) MOD[(l * 5 + j) * 6144 + e] = acc[j] + b;
    }
    __syncthreads();
}

DEVI void hy_mlp_item(ArgsP a, int item, float* wl  , int lane) {
    const int hl = item / 36, r = item % 36, sel = r >= 4, tb = sel ? r - 4 : r, L = sel ? 2048 : 256, tau = tb * 64 + lane;
    float* H3 = (float*)(a->ws + WS_H3) + (size_t)(hl * 2304 + (sel ? 256 : 0) + tau) * 64;
    const float* w1 = a->in[32] + hl * 33 * 64; const float* b1 = a->in[33] + hl * 64; const float* w2 = a->in[34] + hl * 4096; const float* b2 = a->in[35] + hl * 64;
    const float* w3 = a->in[36] + hl * 4096; const float* b3 = a->in[37] + hl * 64; const float* fr = a->in[38] + hl * 192;
    float z[33]; z[0] = (float)tau / (float)(L - 1);
#pragma unroll
    for (int k = 0; k < 16; ++k) { const float f = 1e-4f + (float)k * ((15.f - 1e-4f) / 15.f); const float rev = f * (float)tau / (float)L; z[1 + k] = cos_rev(rev); z[17 + k] = -sin_rev(rev); }
    for (int o = 0; o < 64; ++o) { float acc = b1[o];
#pragma unroll
        for (int i = 0; i < 33; ++i) acc += z[i] * w1[i * 64 + o];
        wl[o * 64 + lane] = sin_rev(fr[o] * acc * INV2PI); }
    LDSW();
    float h[64];
#pragma unroll
    for (int i = 0; i < 64; ++i) h[i] = wl[i * 64 + lane];
    LDSW();
    for (int o = 0; o < 64; ++o) { float acc = b2[o];
#pragma unroll
        for (int i = 0; i < 64; ++i) acc += h[i] * w2[i * 64 + o];
        wl[o * 64 + lane] = sin_rev(fr[64 + o] * acc * INV2PI); }
    LDSW();
#pragma unroll
    for (int i = 0; i < 64; ++i) h[i] = wl[i * 64 + lane];
    LDSW();
    for (int o = 0; o < 64; ++o) { float acc = b3[o];
#pragma unroll
        for (int i = 0; i < 64; ++i) acc += h[i] * w3[i * 64 + o];
        H3[o] = sin_rev(fr[128 + o] * acc * INV2PI); }
}
DEVI void hy_out_item(ArgsP a, int item, float* wl  , int lane) {
    const int cb = item & 31, it2 = item >> 5, hl = it2 / 36, r = it2 % 36, sel = r >= 4, tb = sel ? r - 4 : r, L = sel ? 2048 : 256, tau = tb * 64 + lane;
    const float* H3 = (const float*)(a->ws + WS_H3) + (size_t)(hl * 2304 + (sel ? 256 : 0) + tau) * 64;
    const float* w4 = a->in[39] + (size_t)hl * 64 * 2048 + cb * 64;
#pragma unroll 8
    for (int rr = 0; rr < 64; ++rr) wl[lane * 64 + rr] = w4[(size_t)rr * 2048 + lane];
    float h[64];
#pragma unroll
    for (int i = 0; i < 16; ++i) { const f32x4 t = ((const f32x4*)H3)[i]; h[4 * i] = t[0]; h[4 * i + 1] = t[1]; h[4 * i + 2] = t[2]; h[4 * i + 3] = t[3]; }
    LDSW();
    bf16* HR = (bf16*)(a->ws + WS_HR + (size_t)hl * 9 * MiB + (sel ? 1 * MiB : 0));
    const float t = (float)tau / (float)(L - 1);
    for (int cc = 0; cc < 64; ++cc) {
        float acc = 0.f;
#pragma unroll
        for (int i = 0; i < 16; ++i) { const f32x4 w = *(const f32x4*)(wl + cc * 64 + 4 * i); acc += h[4 * i] * w[0] + h[4 * i + 1] * w[1] + h[4 * i + 2] * w[2] + h[4 * i + 3] * w[3]; }
        const int c = cb * 64 + cc, dir = c >> 10, d = c & 1023;
        const float delta = 3.0701134573253945f + 12.280453829301578f * ((float)d * (1.f / 1023.f));
        float val = acc * __expf(-t * delta);
        int x;
        if (dir == 0) { x = L - tau; if (tau == 0) val += a->in[40][hl * 1024 + d]; }
        else { x = tau == 0 ? 0 : L + tau; if (tau == 0) val = 0.f; }
        HR[(size_t)d * (2 * L) + x] = (bf16)(pk2(val, 0.f) & 0xffffu);
    }
    LDSW();
}
DEVI void blkinfo(int blk, int& sq, int& nb, int& nch) { if (blk < 64) { sq = blk >> 2; nb = blk & 3; nch = 4; } else { sq = 16 + ((blk - 64) >> 5); nb = (blk - 64) & 31; nch = 32; } }
DEVI void gla_la(ArgsP a, int i, int blk, int h, int dir, float* LA, int tid) {
    const bf16* U = (const bf16*)(a->ws + WS_U);
    const int c = tid >> 3, kq = tid & 7, tok = blk * 64 + (dir ? 63 - c : c);
    const u32x4* lp = (const u32x4*)(U + (size_t)tok * UP + 1536 + dir * 16);
    float lr[16]; unpack8(lp[0], lr); unpack8(lp[1], lr + 8);
    const float* wd = a->in[15] + (size_t)((i * 2 + dir) * 16) * 256 + h * 64 + kq * 8; const float* bd = a->in[16] + (i * 2 + dir) * 256 + h * 64 + kq * 8;
#pragma unroll
    for (int e = 0; e < 8; ++e) { float acc = bd[e];
#pragma unroll
        for (int r = 0; r < 16; ++r) acc += lr[r] * wd[r * 256 + e];
        const float ls = fminf(acc, 0.f) - __logf(1.f + __expf(-fabsf(acc)));
        LA[c * 65 + kq * 8 + e] = ls * (1.f / 16.f); }
    __syncthreads();
    if (tid < 64) { float s = 0.f; for (int cc = 0; cc < 64; ++cc) { s += LA[cc * 65 + tid]; LA[cc * 65 + tid] = s; } }
    __syncthreads();
}
DEVI void gla_passA(ArgsP a, int i, unsigned char* lds, int bid, int nb_, int tid) {
    const bf16* U = (const bf16*)(a->ws + WS_U); float* KV = (float*)(a->ws + WS_KV); float* DEC = (float*)(a->ws + WS_DEC);
    float* LA = (float*)lds; bf16* VT = (bf16*)(lds + 16896); bf16* KOT = (bf16*)(lds + 16896 + 18432);
    const int wave = tid >> 6, lane = tid & 63, fr = lane & 15, fq = lane >> 4;
    for (int item = bid; item < 1536; item += nb_) {
        const int dir = item & 1, h = (item >> 1) & 3, blk = item >> 3;
        gla_la(a, i, blk, h, dir, LA, tid);
        { const int c = tid >> 3, part = tid & 7, tok = blk * 64 + (dir ? 63 - c : c);
          const bf16* vp = U + (size_t)tok * UP + 512 + h * 128 + part * 16; const u32x4 v0 = ((const u32x4*)vp)[0], v1 = ((const u32x4*)vp)[1];
          const unsigned vv[8] = {v0.x, v0.y, v0.z, v0.w, v1.x, v1.y, v1.z, v1.w};
#pragma unroll
          for (int e = 0; e < 8; ++e) { VT[(part * 16 + 2 * e) * 72 + c] = (bf16)(vv[e] & 0xffffu); VT[(part * 16 + 2 * e + 1) * 72 + c] = (bf16)(vv[e] >> 16); }
          float kf[8]; unpack8(*(const u32x4*)(U + (size_t)tok * UP + 256 + h * 64 + part * 8), kf);
#pragma unroll
          for (int e = 0; e < 8; ++e) { const int k = part * 8 + e; const float ko = kf[e] * __expf(LA[63 * 65 + k] - LA[c * 65 + k]); KOT[k * 72 + c] = (bf16)(pk2(ko, 0.f) & 0xffffu); }
          if (tid < 64) DEC[(size_t)item * 64 + tid] = __expf(LA[63 * 65 + tid]); }
        __syncthreads();
        f32x4 acc[4];
#pragma unroll
        for (int nt = 0; nt < 4; ++nt) acc[nt] = (f32x4){0.f, 0.f, 0.f, 0.f};
#pragma unroll
        for (int ks = 0; ks < 2; ++ks) { const bf16x8 af = *(const bf16x8*)(VT + (16 * wave + fr) * 72 + fq * 8 + ks * 32);
#pragma unroll
            for (int nt = 0; nt < 4; ++nt) { const bf16x8 bfr = *(const bf16x8*)(KOT + (16 * nt + fr) * 72 + fq * 8 + ks * 32); acc[nt] = mfma16(bfr, af, acc[nt]); } }
#pragma unroll
        for (int nt = 0; nt < 4; ++nt) *(f32x4*)(KV + (size_t)item * 8192 + (16 * wave + fr) * 64 + 16 * nt + 4 * fq) = acc[nt];
        __syncthreads();
    }
}
DEVI void gla_passB(ArgsP a, int i, int gt, int NGT) {
    float* KV = (float*)(a->ws + WS_KV); const float* DEC = (const float*)(a->ws + WS_DEC);
    for (int u = gt; u < 160 * 8192; u += NGT) {
        const int e = u & 8191, ch = u >> 13, dir = ch & 1, h = (ch >> 1) & 3, sq = ch >> 3, v = e >> 6, k = e & 63;
        const int nch = sq < 16 ? 4 : 32, blk0 = sq < 16 ? sq * 4 : 64 + (sq - 16) * 32;
        float S = 0.f;
        if (sq >= 16) S = a->in[2][(size_t)((((sq - 16) * 2 + i) * 2 + dir) * 4 + h) * 8192 + k * 128 + v];
        for (int n = 0; n < nch; ++n) { const int blk = blk0 + (dir ? nch - 1 - n : n); const size_t item = (size_t)((blk * 4 + h) * 2 + dir);
            const float kv = KV[item * 8192 + e]; KV[item * 8192 + e] = S; S = DEC[item * 64 + k] * S + kv; }
        if (sq < 16) a->out[OUT_SG + (size_t)(((sq * 2 + i) * 2 + dir) * 4 + h) * 8192 + k * 128 + v] = S;
    }
}
DEVI void gla_passC(ArgsP a, int i, unsigned char* lds, int bid, int nb_, int tid) {
    const bf16* U = (const bf16*)(a->ws + WS_U); const float* KV = (const float*)(a->ws + WS_KV); bf16* MO = (bf16*)(a->ws + WS_A);
    float* LA = (float*)lds; bf16* QIN = (bf16*)(lds + 16896); bf16* KIN = (bf16*)(lds + 26112); bf16* VT = (bf16*)(lds + 35328); bf16* ST = (bf16*)(lds + 53760);
    bf16* P = (bf16*)(lds + 72192); float* O = (float*)(lds + 81408);
    const int wave = tid >> 6, lane = tid & 63, fr = lane & 15, fq = lane >> 4;
    for (int item = bid; item < 768; item += nb_) {
        const int h = item & 3, blk = item >> 2;
        for (int dir = 0; dir < 2; ++dir) {
            gla_la(a, i, blk, h, dir, LA, tid);
            { const int c = tid >> 3, part = tid & 7, tok = blk * 64 + (dir ? 63 - c : c);
              float qf[8], kf[8]; unpack8(*(const u32x4*)(U + (size_t)tok * UP + h * 64 + part * 8), qf); unpack8(*(const u32x4*)(U + (size_t)tok * UP + 256 + h * 64 + part * 8), kf);
#pragma unroll
              for (int e = 0; e < 8; ++e) { const float cum = LA[c * 65 + part * 8 + e]; qf[e] = qf[e] * __expf(cum) * 0.125f; kf[e] = kf[e] * __expf(-cum); }
              *(u32x4*)(QIN + c * 72 + part * 8) = pack8(qf); *(u32x4*)(KIN + c * 72 + part * 8) = pack8(kf);
              const bf16* vp = U + (size_t)tok * UP + 512 + h * 128 + part * 16; const u32x4 v0 = ((const u32x4*)vp)[0], v1 = ((const u32x4*)vp)[1];
              const unsigned vv[8] = {v0.x, v0.y, v0.z, v0.w, v1.x, v1.y, v1.z, v1.w};
#pragma unroll
              for (int e = 0; e < 8; ++e) { VT[(part * 16 + 2 * e) * 72 + c] = (bf16)(vv[e] & 0xffffu); VT[(part * 16 + 2 * e + 1) * 72 + c] = (bf16)(vv[e] >> 16); }
              const int v = tid >> 2, kq = (tid & 3) * 16; const float* sp = KV + (size_t)((blk * 4 + h) * 2 + dir) * 8192 + v * 64 + kq;
              float sf[16];
#pragma unroll
              for (int e = 0; e < 4; ++e) { const f32x4 t = ((const f32x4*)sp)[e]; sf[4 * e] = t[0]; sf[4 * e + 1] = t[1]; sf[4 * e + 2] = t[2]; sf[4 * e + 3] = t[3]; }
              *(u32x4*)(ST + v * 72 + kq) = pack8(sf); *(u32x4*)(ST + v * 72 + kq + 8) = pack8(sf + 8); }
            __syncthreads();
#pragma unroll
            for (int tt = 0; tt < 2; ++tt) { const int tile = wave * 2 + tt, mt = tile >> 2, nt = tile & 3; f32x4 sc = (f32x4){0.f, 0.f, 0.f, 0.f};
#pragma unroll
                for (int ks = 0; ks < 2; ++ks) { const bf16x8 af = *(const bf16x8*)(QIN + (16 * mt + fr) * 72 + fq * 8 + ks * 32); const bf16x8 bfr = *(const bf16x8*)(KIN + (16 * nt + fr) * 72 + fq * 8 + ks * 32); sc = mfma16(bfr, af, sc); }
                const int c = 16 * mt + fr, s0 = 16 * nt + 4 * fq;
#pragma unroll
                for (int r = 0; r < 4; ++r) if (s0 + r > c) sc[r] = 0.f;
                u32x2 w; w.x = pk2(sc[0], sc[1]); w.y = pk2(sc[2], sc[3]); *(u32x2*)(P + c * 72 + s0) = w; }
            __syncthreads();
            { const int mt = wave >> 1, ntb = (wave & 1) * 4; f32x4 acc[4];
#pragma unroll
              for (int q = 0; q < 4; ++q) acc[q] = (f32x4){0.f, 0.f, 0.f, 0.f};
#pragma unroll
              for (int ks = 0; ks < 2; ++ks) { const bf16x8 af = *(const bf16x8*)(P + (16 * mt + fr) * 72 + fq * 8 + ks * 32);
#pragma unroll
                  for (int q = 0; q < 4; ++q) { const bf16x8 bfr = *(const bf16x8*)(VT + (16 * (ntb + q) + fr) * 72 + fq * 8 + ks * 32); acc[q] = mfma16(bfr, af, acc[q]); } }
#pragma unroll
              for (int ks = 0; ks < 2; ++ks) { const bf16x8 af = *(const bf16x8*)(QIN + (16 * mt + fr) * 72 + fq * 8 + ks * 32);
#pragma unroll
                  for (int q = 0; q < 4; ++q) { const bf16x8 bfr = *(const bf16x8*)(ST + (16 * (ntb + q) + fr) * 72 + fq * 8 + ks * 32); acc[q] = mfma16(bfr, af, acc[q]); } }
              const int c = 16 * mt + fr, row = dir ? 63 - c : c;
#pragma unroll
              for (int q = 0; q < 4; ++q) { f32x4* op = (f32x4*)(O + row * 132 + 16 * (ntb + q) + 4 * fq); if (dir == 0) *op = acc[q]; else *op = *op + acc[q]; } }
            __syncthreads();
        }
        for (int rr = 0; rr < 8; ++rr) { const int row = wave * 8 + rr, tok = blk * 64 + row;
            const float o0 = O[row * 132 + 2 * lane], o1 = O[row * 132 + 2 * lane + 1];
            const float ss = wave_sum(o0 * o0 + o1 * o1); const float sc = 1.f / sqrtf(ss * (1.f / 128.f) + 1e-5f);
            const float n0 = a->in[17][i * 128 + 2 * lane], n1 = a->in[17][i * 128 + 2 * lane + 1];
            const unsigned gg = *(const unsigned*)(U + (size_t)tok * UP + 1024 + h * 128 + 2 * lane); const float g0 = bflo(gg), g1 = bfhi(gg);
            *(unsigned*)(MO + (size_t)tok * 1024 + h * 128 + 2 * lane) = pk2(o0 * sc * n0 * g0 * sigm(g0), o1 * sc * n1 * g1 * sigm(g1)); }
        __syncthreads();
    }
}

DEVI void rwkv_xprep(ArgsP a, int i, int gw, int NGW, int lane) {
    const bf16* U = (const bf16*)(a->ws + WS_U); bf16* X = (bf16*)(a->ws + WS_X);
    const float* mu0 = a->in[18] + (size_t)(i * 2) * 1952 + 1536 + lane * 8; const float* mu1 = mu0 + 1952;
    for (int tok = gw; tok < NTOK; tok += NGW) {
        u32x4 o = (u32x4){0u, 0u, 0u, 0u};
        if (lane < 52) { int tok0, L; tokinfo(tok, tok0, L); const bf16* p = U + (size_t)tok * UP + 3104 + lane * 8;
            float x[8], xp[8], xn[8]; unpack8(*(const u32x4*)p, x);
            if (tok > tok0) unpack8(*(const u32x4*)(p - UP), xp); else { for (int e = 0; e < 8; ++e) xp[e] = 0.f; }
            if (tok < tok0 + L - 1) unpack8(*(const u32x4*)(p + UP), xn); else { for (int e = 0; e < 8; ++e) xn[e] = 0.f; }
#pragma unroll
            for (int e = 0; e < 8; ++e) { float s = x[e] + mu0[e] * (xp[e] - x[e]) + mu1[e] * (xn[e] - x[e]);
                if (lane < 16) s = 1.f - 2.f / (1.f + __expf(2.f * s)); else if (lane >= 32) s = sigm(s);
                x[e] = s; }
            o = pack8(x); }
        *(u32x4*)(X + (size_t)tok * 512 + lane * 8) = o;
    }
}
struct StageRegs { u32x2 r[3], k[3], v[3], wl, al; };
DEVI void st_load(StageRegs& R, const bf16* U, const bf16* LO, int tok, bool hp, bool hn, int cr, int dir) {
    const bf16* p = U + (size_t)tok * UP + 1568 + cr; const u32x2 z = (u32x2){0u, 0u};
    R.r[1] = *(const u32x2*)p; R.k[1] = *(const u32x2*)(p + 512); R.v[1] = *(const u32x2*)(p + 1024);
    if (hp) { R.r[0] = *(const u32x2*)(p - UP); R.k[0] = *(const u32x2*)(p - UP + 512); R.v[0] = *(const u32x2*)(p - UP + 1024); } else { R.r[0] = z; R.k[0] = z; R.v[0] = z; }
    if (hn) { R.r[2] = *(const u32x2*)(p + UP); R.k[2] = *(const u32x2*)(p + UP + 512); R.v[2] = *(const u32x2*)(p + UP + 1024); } else { R.r[2] = z; R.k[2] = z; R.v[2] = z; }
    const bf16* q = LO + (size_t)tok * LOP + dir * 512 + cr; R.wl = *(const u32x2*)q; R.al = *(const u32x2*)(q + 1024);
}
DEVI void un4(const u32x2 w, float* f) { f[0] = bflo(w.x); f[1] = bfhi(w.x); f[2] = bflo(w.y); f[3] = bfhi(w.y); }
DEVI void rwkv_scan_item(ArgsP a, int i, int item, unsigned char* lds, int tid) {
    const int half = item & 1, dir = (item >> 1) & 1, h = (item >> 2) & 7, sq = item >> 5;
    const int L = sq < 16 ? 256 : 2048, tok0 = sq < 16 ? sq * 256 : 4096 + (sq - 16) * 2048, nch = L / 32;
    const bf16* U = (const bf16*)(a->ws + WS_U); const bf16* LO = (const bf16*)(a->ws + WS_LO); float* Y = (float*)(a->ws + WS_Y) + (size_t)dir * NTOK * 512;
    const int wave = tid >> 6, lane = tid & 63;
    const int ss_ = tid >> 4, jq = tid & 15, cr = h * 64 + jq * 4;
    float m0r[4], m1r[4], m0k[4], m1k[4], m0v[4], m1v[4], w0[4], a0[4], kkc[4], kac[4];
    { const float* mu0 = a->in[18] + (size_t)(i * 2) * 1952 + cr; const float* mu1 = mu0 + 1952;
#pragma unroll
      for (int e = 0; e < 4; ++e) { m0r[e] = mu0[e]; m1r[e] = mu1[e]; m0k[e] = mu0[512 + e]; m1k[e] = mu1[512 + e]; m0v[e] = mu0[1024 + e]; m1v[e] = mu1[1024 + e];
          w0[e] = a->in[19][(i * 2 + dir) * 512 + cr + e]; a0[e] = a->in[21][(i * 2 + dir) * 512 + cr + e]; kkc[e] = a->in[24][i * 512 + cr + e]; kac[e] = a->in[25][i * 512 + cr + e]; } }
    const int row = half * 32 + wave * 4 + (lane >> 4), jp = lane & 15;
    f32x4 st = (f32x4){0.f, 0.f, 0.f, 0.f};
    if (sq >= 16) st = *(const f32x4*)(a->in[3] + (size_t)(((((sq - 16) * 2 + i) * 2 + dir) * 8 + h) * 64 + row) * 64 + 4 * jp);
    StageRegs R;
#define STAGE_LOAD(ch) do { const int tt_ = (ch) * 32 + ss_; const int tl_ = dir ? L - 1 - tt_ : tt_; st_load(R, U, LO, tok0 + tl_, tl_ > 0, tl_ < L - 1, cr, dir); } while (0)
#define STAGE_STORE(bufp) do { float* B_ = (float*)(bufp); float rc[4], rp[4], rn[4], kc[4], kp[4], kn[4], vc[4], vp[4], vn[4], wl[4], al[4]; \
        un4(R.r[1], rc); un4(R.r[0], rp); un4(R.r[2], rn); un4(R.k[1], kc); un4(R.k[0], kp); un4(R.k[2], kn); un4(R.v[1], vc); un4(R.v[0], vp); un4(R.v[2], vn); un4(R.wl, wl); un4(R.al, al); \
        f32x4 o_kk, o_w, o_ka, o_kd, o_r, o_v; float kk_[4]; float ssq = 0.f; \
        _Pragma("unroll") for (int e = 0; e < 4; ++e) { const float rs = rc[e] + m0r[e] * (rp[e] - rc[e]) + m1r[e] * (rn[e] - rc[e]); const float ks = kc[e] + m0k[e] * (kp[e] - kc[e]) + m1k[e] * (kn[e] - kc[e]); \
            const float vs = vc[e] + m0v[e] * (vp[e] - vc[e]) + m1v[e] * (vn[e] - vc[e]); kk_[e] = ks * kkc[e]; ssq += kk_[e] * kk_[e]; \
            const float av = sigm(a0[e] + al[e]); const float xw = -(w0[e] + wl[e]); const float sp = fmaxf(xw, 0.f) + __logf(1.f + __expf(-fabsf(xw))); \
            o_w[e] = __expf(-__expf(-sp - 0.5f)); o_r[e] = rs; o_v[e] = vs; o_kd[e] = ks * (1.f + (av - 1.f) * kac[e]); o_ka[e] = av; } \
        ssq = red16(ssq); const float inv = 1.f / fmaxf(sqrtf(ssq), 1e-12f); \
        _Pragma("unroll") for (int e = 0; e < 4; ++e) { o_kk[e] = kk_[e] * inv; o_ka[e] = o_kk[e] * o_ka[e]; } \
        const int o_ = ss_ * 64 + jq * 4; *(f32x4*)(B_ + o_) = o_kk; *(f32x4*)(B_ + 2048 + o_) = o_w; *(f32x4*)(B_ + 4096 + o_) = o_ka; *(f32x4*)(B_ + 6144 + o_) = o_kd; *(f32x4*)(B_ + 8192 + o_) = o_r; *(f32x4*)(B_ + 10240 + o_) = o_v; } while (0)
    STAGE_LOAD(0); STAGE_STORE(lds); __syncthreads();
    for (int ch = 0; ch < nch; ++ch) {
        if (ch + 1 < nch) STAGE_LOAD(ch + 1);
        const float* B = (const float*)(lds + (ch & 1) * 49152);
        for (int s = 0; s < 32; ++s) {
            const f32x4 kk = *(const f32x4*)(B + s * 64 + 4 * jp), w = *(const f32x4*)(B + 2048 + s * 64 + 4 * jp), ka = *(const f32x4*)(B + 4096 + s * 64 + 4 * jp),
                        kd = *(const f32x4*)(B + 6144 + s * 64 + 4 * jp), r = *(const f32x4*)(B + 8192 + s * 64 + 4 * jp); const float vi = B[10240 + s * 64 + row];
            float sa = -((st[0] * kk[0] + st[1] * kk[1]) + (st[2] * kk[2] + st[3] * kk[3])); sa = red16(sa);
#pragma unroll
            for (int e = 0; e < 4; ++e) st[e] = st[e] * w[e] + (sa * ka[e] + vi * kd[e]);
            float y = (st[0] * r[0] + st[1] * r[1]) + (st[2] * r[2] + st[3] * r[3]); y = red16(y);
            if (jp == 0) { const int tt = ch * 32 + s, tl = dir ? L - 1 - tt : tt; Y[(size_t)(tok0 + tl) * 512 + h * 64 + row] = y; }
        }
        if (ch + 1 < nch) STAGE_STORE(lds + ((ch + 1) & 1) * 49152);
        __syncthreads();
    }
#undef STAGE_LOAD
#undef STAGE_STORE
    if (sq < 16) *(f32x4*)(a->out + OUT_SR + (size_t)(((((sq * 2 + i) * 2 + dir) * 8 + h) * 64 + row) * 64) + 4 * jp) = st;
}
DEVI void rwkv_scan_phase(ArgsP a, int i, unsigned char* lds, int bid, int nb_, int tid) {
    if (nb_ == 256) { if (bid < 128) rwkv_scan_item(a, i, 512 + bid, lds, tid); else for (int q = 0; q < 4; ++q) rwkv_scan_item(a, i, (bid - 128) * 4 + q, lds, tid); }
    else for (int it = bid; it < 640; it += nb_) rwkv_scan_item(a, i, 639 - it, lds, tid);
}
DEVI void rwkv_post(ArgsP a, int i, int gw, int NGW, int lane) {
    const bf16* U = (const bf16*)(a->ws + WS_U); const bf16* LO = (const bf16*)(a->ws + WS_LO); const float* Y = (const float*)(a->ws + WS_Y); bf16* MO = (bf16*)(a->ws + WS_A);
    const int c8 = lane * 8; const float* mu0 = a->in[18] + (size_t)(i * 2) * 1952 + c8; const float* mu1 = mu0 + 1952;
    for (int tok = gw; tok < NTOK; tok += NGW) {
        int tok0, L; tokinfo(tok, tok0, L); const bool hp = tok > tok0, hn = tok < tok0 + L - 1;
        const bf16* p = U + (size_t)tok * UP + 1568 + c8; float sh[3][8];
#pragma unroll
        for (int m = 0; m < 3; ++m) { float x[8], xp[8], xn[8]; unpack8(*(const u32x4*)(p + m * 512), x);
            if (hp) unpack8(*(const u32x4*)(p + m * 512 - UP), xp); else { for (int e = 0; e < 8; ++e) xp[e] = 0.f; }
            if (hn) unpack8(*(const u32x4*)(p + m * 512 + UP), xn); else { for (int e = 0; e < 8; ++e) xn[e] = 0.f; }
#pragma unroll
            for (int e = 0; e < 8; ++e) sh[m][e] = x[e] + mu0[m * 512 + e] * (xp[e] - x[e]) + mu1[m * 512 + e] * (xn[e] - x[e]); }
        float y[8]; { const f32x4 a0 = *(const f32x4*)(Y + (size_t)tok * 512 + c8), a1 = *(const f32x4*)(Y + (size_t)tok * 512 + c8 + 4);
            const f32x4 b0 = *(const f32x4*)(Y + (size_t)(NTOK + tok) * 512 + c8), b1 = *(const f32x4*)(Y + (size_t)(NTOK + tok) * 512 + c8 + 4);
#pragma unroll
            for (int e = 0; e < 4; ++e) { y[e] = a0[e] + b0[e]; y[4 + e] = a1[e] + b1[e]; } }
        float s = 0.f, bon = 0.f;
#pragma unroll
        for (int e = 0; e < 8; ++e) { s += y[e]; bon += sh[0][e] * sh[1][e] * a->in[26][i * 512 + c8 + e]; }
        const float mean = red8(s) * (1.f / 64.f); bon = red8(bon); float q = 0.f;
#pragma unroll
        for (int e = 0; e < 8; ++e) { y[e] -= mean; q += y[e] * y[e]; }
        const float rs = 1.f / sqrtf(red8(q) * (1.f / 64.f) + 64e-5f);
        float g[8]; unpack8(*(const u32x4*)(LO + (size_t)tok * LOP + 2048 + c8), g);
#pragma unroll
        for (int e = 0; e < 8; ++e) y[e] = (y[e] * rs * a->in[27][i * 512 + c8 + e] + a->in[28][i * 512 + c8 + e] + bon * sh[2][e]) * g[e];
        *(u32x4*)(MO + (size_t)tok * 1024 + 512 + c8) = pack8(y);
    }
}

DEVI void hy_conv_phase(ArgsP a, int hl, unsigned char* lds, int bid, int nb_, int tid) {
    const bf16* U = (const bf16*)(a->ws + WS_U); bf16* VGT = (bf16*)(a->ws + WS_VGT); bf16* X0C = (bf16*)(a->ws + WS_X0C); bf16* T = (bf16*)lds;
    const float* cw = a->in[30] + (size_t)hl * 3 * 3072; const float* cb = a->in[31] + (size_t)hl * 3072;
    for (int item = bid; item < 192 * 16; item += nb_) {
        const int dblk = item & 15, blk = item >> 4;
        { const int t = tid >> 3, dg = tid & 7, tok = blk * 64 + t; int tok0, L; tokinfo(tok, tok0, L); const bool hp = tok > tok0, hn = tok < tok0 + L - 1;
          float cv[3][8];
#pragma unroll
          for (int m = 0; m < 3; ++m) { const int col = m * 1024 + dblk * 64 + dg * 8; const bf16* p = U + (size_t)tok * HP + col; float x[8], xp[8], xn[8]; unpack8(*(const u32x4*)p, x);
              if (hp) unpack8(*(const u32x4*)(p - HP), xp); else { for (int e = 0; e < 8; ++e) xp[e] = 0.f; }
              if (hn) unpack8(*(const u32x4*)(p + HP), xn); else { for (int e = 0; e < 8; ++e) xn[e] = 0.f; }
#pragma unroll
              for (int e = 0; e < 8; ++e) cv[m][e] = xp[e] * cw[col + e] + x[e] * cw[3072 + col + e] + xn[e] * cw[6144 + col + e] + cb[col + e]; }
          *(u32x4*)(X0C + (size_t)tok * 1024 + dblk * 64 + dg * 8) = pack8(cv[0]);
#pragma unroll
          for (int e = 0; e < 8; ++e) T[(dg * 8 + e) * 72 + t] = (bf16)(pk2(cv[2][e] * cv[1][e], 0.f) & 0xffffu); }
        __syncthreads();
        { const int dd = tid >> 3, tq = tid & 7; *(u32x4*)(VGT + (size_t)(dblk * 64 + dd) * NTOK + blk * 64 + tq * 8) = *(const u32x4*)(T + dd * 72 + tq * 8); }
        __syncthreads();
    }
}
template <int L, int NBAT>
DEVI void toeplitz_group(const bf16* HRrow, const bf16* VGTd, bf16* YTd, int tokbase, unsigned char* lds, int tid) {
    constexpr int NB1 = L / 64, M = NB1 * NBAT, MT = M / 16, NTW = 4 * MT / 8, CPS = 2 * L + 8, NG = 2 * L / 8 + 1;
    bf16* HRAW = (bf16*)lds; bf16* CP = (bf16*)(lds + 8192 + 16); bf16* VL = (bf16*)(lds + 8192 + 16 + 8 * (2 * 2048 + 8) * 2);
    const int wave = tid >> 6, lane = tid & 63, fr = lane & 15, fq = lane >> 4;
    for (int u = tid; u < 2 * L / 8; u += 512) *(u32x4*)(HRAW + u * 8) = *(const u32x4*)(HRrow + u * 8);
    for (int u = tid; u < NBAT * L / 8; u += 512) *(u32x4*)(VL + u * 8) = *(const u32x4*)(VGTd + tokbase + u * 8);
    __syncthreads();
    for (int g = tid; g < 8 * NG; g += 512) { const int c = g / NG, gi = g % NG; unsigned w[4];
#pragma unroll
        for (int e = 0; e < 4; ++e) { const int i0 = gi * 8 + c + 2 * e, i1 = i0 + 1; const unsigned lo = i0 < 2 * L ? HRAW[i0] : 0u, hi = i1 < 2 * L ? HRAW[i1] : 0u; w[e] = lo | (hi << 16); }
        *(u32x4*)(CP + c * CPS + gi * 8) = (u32x4){w[0], w[1], w[2], w[3]}; }
    __syncthreads();
    const int mt = wave % MT, nt0 = (wave / MT) * NTW, m = mt * 16 + fr, t1 = m / NBAT, b = m % NBAT;
    const int t1lo = (mt * 16) / NBAT, t1hi = (mt * 16 + 15) / NBAT;
    f32x4 acc[NTW];
#pragma unroll
    for (int q = 0; q < NTW; ++q) acc[q] = (f32x4){0.f, 0.f, 0.f, 0.f};
    for (int delta = t1lo - (NB1 - 1); delta <= t1hi; ++delta) {
        const int s1 = t1 - delta; const bool valid = s1 >= 0 && s1 < NB1;
#pragma unroll
        for (int ks = 0; ks < 2; ++ks) { const int k0 = ks * 32 + fq * 8;
            bf16x8 af = (bf16x8){0, 0, 0, 0, 0, 0, 0, 0}; if (valid) af = *(const bf16x8*)(VL + b * L + s1 * 64 + k0);
#pragma unroll
            for (int q = 0; q < NTW; ++q) { const int n = (nt0 + q) * 16 + fr; const int qq = k0 - n - 64 * delta + L; const int c = qq & 7;
                const bf16x8 bfr = *(const bf16x8*)(CP + c * CPS + (qq - c)); acc[q] = mfma16(bfr, af, acc[q]); } }
    }
#pragma unroll
    for (int q = 0; q < NTW; ++q) { u32x2 w; w.x = pk2(acc[q][0], acc[q][1]); w.y = pk2(acc[q][2], acc[q][3]);
        *(u32x2*)(YTd + tokbase + b * L + t1 * 64 + (nt0 + q) * 16 + 4 * fq) = w; }
    __syncthreads();
}
DEVI void hy_toeplitz_phase(ArgsP a, int hl, unsigned char* lds, int bid, int nb_, int tid) {
    const bf16* VGT = (const bf16*)(a->ws + WS_VGT); bf16* YT = (bf16*)(a->ws + WS_YT);
    const bf16* HR0 = (const bf16*)(a->ws + WS_HR + (size_t)hl * 9 * MiB); const bf16* HR1 = (const bf16*)(a->ws + WS_HR + (size_t)hl * 9 * MiB + 1 * MiB);
    for (int d = bid; d < 1024; d += nb_) {
        toeplitz_group<2048, 4>(HR1 + (size_t)d * 4096, VGT + (size_t)d * NTOK, YT + (size_t)d * NTOK, 4096, lds, tid);
        toeplitz_group<256, 16>(HR0 + (size_t)d * 512, VGT + (size_t)d * NTOK, YT + (size_t)d * NTOK, 0, lds, tid);
    }
}
DEVI void hy_back_phase(ArgsP a, unsigned char* lds, int bid, int nb_, int tid) {
    const bf16* YT = (const bf16*)(a->ws + WS_YT); const bf16* X0C = (const bf16*)(a->ws + WS_X0C); bf16* A2 = (bf16*)(a->ws + WS_A); bf16* T = (bf16*)lds;
    for (int item = bid; item < 192 * 16; item += nb_) {
        const int dblk = item & 15, blk = item >> 4;
        { const int dd = tid >> 3, tq = tid & 7; const u32x4 w = *(const u32x4*)(YT + (size_t)(dblk * 64 + dd) * NTOK + blk * 64 + tq * 8); const unsigned ww[4] = {w.x, w.y, w.z, w.w};
#pragma unroll
          for (int e = 0; e < 4; ++e) { T[(tq * 8 + 2 * e) * 72 + dd] = (bf16)(ww[e] & 0xffffu); T[(tq * 8 + 2 * e + 1) * 72 + dd] = (bf16)(ww[e] >> 16); } }
        __syncthreads();
        { const int t = tid >> 3, dg = tid & 7, tok = blk * 64 + t; float y[8], x0[8]; unpack8(*(const u32x4*)(T + t * 72 + dg * 8), y); unpack8(*(const u32x4*)(X0C + (size_t)tok * 1024 + dblk * 64 + dg * 8), x0);
#pragma unroll
          for (int e = 0; e < 8; ++e) y[e] *= x0[e];
          *(u32x4*)(A2 + (size_t)tok * 1024 + dblk * 64 + dg * 8) = pack8(y); }
        __syncthreads();
    }
}
#ifndef MK_ONE_LAUNCH
#define MK_ONE_LAUNCH 1
#endif
#ifndef PHMASK
#define PHMASK 0xFFFFu
#endif
#define PHON(k) ((PHMASK >> (k)) & 1u)
constexpr int N_PHASES = 42;
typedef pg8::bf16_t gb16;

template <class Epi>
DEVI void run_gemm(unsigned char* lds, const void* A, const void* Bt, int N, int K, const Epi& E) {
    int bid_ = blockIdx.x, nb_ = gridDim.x; asm volatile("" : "+s"(bid_), "+s"(nb_));
    pg8::Gemm g{(const gb16*)A, (const gb16*)Bt, NTOK, N, K}; pg8::StaticOrder S; S.init(NTOK, N, nb_, bid_);
    pg8::gemm_phase<Epi, pg8::StaticOrder, true, true>((PG8_LAS unsigned char*)lds, g, S, E);
}

__global__ void __launch_bounds__(512, 2) mk(const Args a0) {
    extern __shared__ __attribute__((aligned(16))) unsigned char lds[];
    const int ph_lo = ((ArgsP)__builtin_amdgcn_kernarg_segment_ptr())->ph_lo, ph_hi = ((ArgsP)__builtin_amdgcn_kernarg_segment_ptr())->ph_hi;
#pragma clang loop unroll(disable)
    for (int ph = ph_lo; ph < ph_hi; ++ph) {
#define LA_ ArgsP a = (ArgsP)__builtin_amdgcn_kernarg_segment_ptr(); asm volatile("" : "+s"(a)); unsigned char* ws = a->ws; float* MOD = (float*)(ws + WS_MOD); (void)MOD
        int tid = threadIdx.x; asm volatile("" : "+v"(tid));
        const int lane = tid & 63, wave = __builtin_amdgcn_readfirstlane(tid >> 6);
        int bid = blockIdx.x, nb = gridDim.x; asm volatile("" : "+s"(bid), "+s"(nb));
        const int gw = bid * 8 + wave, NGW = nb * 8, gt = bid * 512 + tid, NGT = nb * 512;
        float* wscr = (float*)(lds + wave * 16384);
        if (ph == 0) { if (PHON(0)) { LA_;
            mods_phase(a, (float*)lds, bid, nb, tid);
            for (int it = gw; it < 72; it += NGW) hy_mlp_item(a, it, wscr, lane);
            convert_mix(a, 0, wscr, gw, NGW, lane);
            convert_ffn(a, 0, wscr, gw, NGW, lane); }
        } else if (ph == 1) { if (PHON(1)) { LA_;
            ln_mod_rows(a, 0, nullptr, nullptr, MOD, gw, NGW, lane);
            for (int it = gw; it < 72 * 32; it += NGW) hy_out_item(a, it, wscr, lane); }
        } else {
            const int l = (ph - 2) / 10, s = (ph - 2) % 10, i = l >> 1; const bool even = (l & 1) == 0;
            if (s == 0) { if (PHON(2)) { LA_;
                const int npad = even ? UP : HP;
                run_gemm(lds, ws + WS_A, ws + WS_WMIX, npad, 1024, pg8::EpiStoreBf16{(gb16*)(ws + WS_U), npad}); }
            } else if (s == 1) {
                if (even) { if (PHON(3)) { LA_; rwkv_xprep(a, i, gw, NGW, lane); gla_passA(a, i, lds, bid, nb, tid); } }
                else { if (PHON(4)) { LA_; hy_conv_phase(a, i, lds, bid, nb, tid); } }
            } else if (s == 2) {
                if (even) { if (PHON(5)) { LA_; gla_passB(a, i, gt, NGT); __syncthreads(); run_gemm(lds, ws + WS_X, ws + WS_WMIX + 9 * MiB, 2560, 512, pg8::EpiStoreBf16{(gb16*)(ws + WS_LO), LOP}); } }
                else { if (PHON(6)) { LA_; hy_toeplitz_phase(a, i, lds, bid, nb, tid); } }
            } else if (s == 3) {
                if (even) { if (PHON(7)) { LA_; rwkv_scan_phase(a, i, lds, bid, nb, tid); } }
                else { if (PHON(8)) { LA_; hy_back_phase(a, lds, bid, nb, tid); } }
            } else if (s == 4) {
                if (even && PHON(9)) { LA_; gla_passC(a, i, lds, bid, nb, tid); rwkv_post(a, i, gw, NGW, lane); }
            } else if (s == 5) {
                if (PHON(10)) { LA_; run_gemm(lds, ws + WS_A, ws + WS_WMIX + 7 * MiB, 1024, 1024, pg8::EpiRes{a->out, MOD + (size_t)l * 5 * 6144 + 2048, ALPHA_F}); }
            } else if (s == 6) { if (PHON(11)) { LA_; const float* modl = MOD + (size_t)l * 5 * 6144;
                ln_mod_rows(a, 1, a->in[8] + (size_t)(l * 2) * 1024, a->in[9] + (size_t)(l * 2) * 1024, modl + 3072, gw, NGW, lane);
                if (l < 3) convert_mix(a, l + 1, wscr, gw, NGW, lane); }
            } else if (s == 7) {
                if (PHON(12)) { LA_; run_gemm(lds, ws + WS_A, ws + WS_WFFN, 5632, 1024, pg8::EpiSwiGLU{(gb16*)(ws + WS_U), FFP}); }
            } else if (s == 8) {
                if (PHON(13)) { LA_; run_gemm(lds, ws + WS_U, ws + WS_WFFN + 11 * MiB, 1024, 2816, pg8::EpiRes{a->out, MOD + (size_t)l * 5 * 6144 + 5120, ALPHA_F}); }
            } else { if (PHON(14)) { LA_;
                ln_mod_rows(a, 1, a->in[8] + (size_t)(l * 2 + 1) * 1024, a->in[9] + (size_t)(l * 2 + 1) * 1024, l < 3 ? MOD + (size_t)(l + 1) * 5 * 6144 : nullptr, gw, NGW, lane);
                if (l < 3) convert_ffn(a, l + 1, wscr, gw, NGW, lane); }
            }
        }
        if (ph + 1 < ph_hi) { __threadfence(); cg::this_grid().sync(); }
    }
}

extern "C" void kernel_launch(void* const* d_in, const int* in_sizes, int n_in, void* d_out, int out_size, void* d_ws, size_t ws_size, hipStream_t stream) {
    static int grid = 0;
    if (grid == 0) {
        if (n_in != 42 || ws_size < WS_END) { fprintf(stderr, "kernel_launch: unexpected n_in %d / ws %zu\n", n_in, ws_size); grid = -1; return; }
        int dev = 0, cus = 0, per_cu = 0;
        hipGetDevice(&dev); hipDeviceGetAttribute(&cus, hipDeviceAttributeMultiprocessorCount, dev);
        if (hipFuncSetAttribute((const void*)mk, hipFuncAttributeMaxDynamicSharedMemorySize, LDS_BYTES) != hipSuccess) { fprintf(stderr, "kernel_launch: hipFuncSetAttribute failed\n"); grid = -1; return; }
        hipOccupancyMaxActiveBlocksPerMultiprocessor(&per_cu, (const void*)mk, 512, LDS_BYTES);
        (void)hipGetLastError();
        if (per_cu < 1) per_cu = 1;
        grid = cus * 1;
        fprintf(stderr, "kernel_launch: cus %d per_cu %d grid %d\n", cus, per_cu, grid);
    }
    if (grid < 0) return;
    Args a{};
    for (int k = 0; k < 42; ++k) a.in[k] = (const float*)d_in[k];
    a.out = (float*)d_out; a.ws = (unsigned char*)d_ws;
#if MK_ONE_LAUNCH
    a.ph_lo = 0; a.ph_hi = N_PHASES;
    void* args[] = {&a};
    hipError_t e = hipLaunchCooperativeKernel((const void*)mk, dim3(grid), dim3(512), args, LDS_BYTES, stream);
    if (e != hipSuccess) fprintf(stderr, "cooperative launch failed: %s (grid %d)\n", hipGetErrorString(e), grid);
#else
    for (int ph = 0; ph < N_PHASES; ++ph) {
        if (ph >= 2 && ((ph - 2) / 10) % 2 == 1 && (ph - 2) % 10 == 4) continue;
        a.ph_lo = ph; a.ph_hi = ph + 1;
        hipLaunchKernelGGL(mk, dim3(grid), dim3(512), LDS_BYTES, stream, a);
    }
#endif
}
```

```cpp
#include <hip/hip_runtime.h>
#include <hip/hip_cooperative_groups.h>
#include <cstdio>
#include <cstdint>
namespace cg = cooperative_groups;
#define MK_ONE_LAUNCH 1
namespace pg8 {
#define PG8_LAS __attribute__((address_space(3)))
typedef unsigned short bf16_t;
typedef short bf16x8 __attribute__((ext_vector_type(8)));
typedef float f32x4 __attribute__((ext_vector_type(4)));
typedef unsigned u32x4 __attribute__((ext_vector_type(4)));
constexpr int BM = 256, BK = 64, HALF = 128, HTB = HALF * BK * 2  , STAGE_BYTES = 8 * HTB, NXCD = 8, WGM = 8;

__host__ __device__ __forceinline__ int lds_byte(int r, int c) { const int st = (r >> 4) * 2 + (c >> 5), rr = r & 15, cc = c & 31, ob = rr * 64 + cc * 2; return st * 1024 + (ob ^ (((ob >> 9) & 1) << 5)); }
__host__ __device__ __forceinline__ void stage_rc(int b, int& R, int& C) { const int st = b / 1024, sb = b % 1024, swz = sb ^ (((sb >> 9) & 1) << 5); R = (st >> 1) * 16 + swz / 64; C = (st & 1) * 32 + (swz % 64) / 2; }
__host__ __device__ __forceinline__ int perm32(int rho) { const int n = rho >> 4, i = rho & 15; return 8 * (i >> 2) + 4 * n + (i & 3); }

struct Unit { int pm, pn; };
struct Gemm { const bf16_t* A; const bf16_t* Bt; int M, N, K; };

struct StaticOrder {
    int nM, nN, nwg, G, c;
    __host__ __device__ void init(int M, int N, int G_, int c_) { nM = M / BM; nN = N / BM; nwg = nM * nN; G = G_; c = c_; }
    __host__ __device__ bool next(int i, Unit& u) const {
        const long L = (long)i * G + c; if (L >= nwg) return false;
        int wgid = (int)L; { const int q = nwg / NXCD, r = nwg % NXCD, xcd = wgid % NXCD, off = wgid / NXCD; wgid = (xcd < r ? xcd * (q + 1) : r * (q + 1) + (xcd - r) * q) + off; }
        const int nig = WGM * nN, gid = wgid / nig, fm = gid * WGM, gsz = (nM - fm) < WGM ? (nM - fm) : WGM;
        u.pm = fm + ((wgid % nig) % gsz); u.pn = (wgid % nig) / gsz; return true;
    }
    __device__ __forceinline__ void a_ready(const Unit&) const {}
    __device__ __forceinline__ void done(const Unit&) const {}
};

__device__ __forceinline__ unsigned cvt_pk_bf16(float lo, float hi) { unsigned r; asm volatile("v_cvt_pk_bf16_f32 %0, %1, %2" : "=v"(r) : "v"(lo), "v"(hi)); return r; }
typedef unsigned u32x2 __attribute__((ext_vector_type(2)));
struct EpiStoreBf16 {
    static constexpr bool PERM = false, AFTER_DRAIN = false;
    bf16_t* O; int ldc;
    __device__ __forceinline__ void operator()(const f32x4 (&acc)[2][2][4][2], const Unit& u, int wr, int wc, int fr, int fq) const {
        const int row0 = u.pm * BM + wr * 64 + fr, col0 = u.pn * BM + wc * 32 + 4 * fq;
#pragma unroll
        for (int ai = 0; ai < 2; ++ai)
#pragma unroll
            for (int m = 0; m < 4; ++m) { bf16_t* rowp = O + (size_t)(row0 + ai * HALF + m * 16) * ldc + col0;
#pragma unroll
                for (int bj = 0; bj < 2; ++bj)
#pragma unroll
                    for (int n = 0; n < 2; ++n) { const f32x4 v = acc[ai][bj][m][n]; u32x2 w; w.x = cvt_pk_bf16(v[0], v[1]); w.y = cvt_pk_bf16(v[2], v[3]);
                        *(u32x2*)(rowp + bj * HALF + n * 16) = w; } }
    }
};
struct EpiSwiGLU {
    static constexpr bool PERM = false, AFTER_DRAIN = false;
    bf16_t* O; int ldc;
    __device__ __forceinline__ void operator()(const f32x4 (&acc)[2][2][4][2], const Unit& u, int wr, int wc, int fr, int fq) const {
        const int row0 = u.pm * BM + wr * 64 + fr, col0 = u.pn * BM + wc * 32 + 4 * fq;
#pragma unroll
        for (int ai = 0; ai < 2; ++ai)
#pragma unroll
            for (int m = 0; m < 4; ++m) { bf16_t* rowp = O + (size_t)(row0 + ai * HALF + m * 16) * ldc;
#pragma unroll
                for (int bj = 0; bj < 2; ++bj)
#pragma unroll
                    for (int n = 0; n < 2; ++n) { const f32x4 v = acc[ai][bj][m][n];
                        const float a0 = v[0] * __builtin_amdgcn_rcpf(1.f + __expf(-v[0])) * v[1];
                        const float a1 = v[2] * __builtin_amdgcn_rcpf(1.f + __expf(-v[2])) * v[3];
                        *(unsigned*)(rowp + ((col0 + bj * HALF + n * 16) >> 1)) = cvt_pk_bf16(a0, a1); } }
    }
};
struct EpiRes {
    static constexpr bool PERM = false, AFTER_DRAIN = false;
    float* X; const float* gate; float alpha;
    __device__ __forceinline__ void operator()(const f32x4 (&acc)[2][2][4][2], const Unit& u, int wr, int wc, int fr, int fq) const {
        const int row0 = u.pm * BM + wr * 64 + fr, col0 = u.pn * BM + wc * 32 + 4 * fq;
        const int ci = u.pm < 16 ? 0 : 1 + ((u.pm - 16) >> 3);
        const float* gp = gate + ci * 6144 + col0;
        f32x4 gv[2][2];
#pragma unroll
        for (int bj = 0; bj < 2; ++bj)
#pragma unroll
            for (int n = 0; n < 2; ++n) gv[bj][n] = *(const f32x4*)(gp + bj * HALF + n * 16);
#pragma unroll
        for (int ai = 0; ai < 2; ++ai)
#pragma unroll
            for (int m = 0; m < 4; ++m) { float* rowp = X + (size_t)(row0 + ai * HALF + m * 16) * 1024 + col0;
#pragma unroll
                for (int bj = 0; bj < 2; ++bj)
#pragma unroll
                    for (int n = 0; n < 2; ++n) { f32x4* p = (f32x4*)(rowp + bj * HALF + n * 16); const f32x4 xv = *p; *p = xv * alpha + gv[bj][n] * acc[ai][bj][m][n]; } }
    }
};
template <class Epi, class Sched, bool ALIGN_EPI = false, bool SP2 = false>
__device__ __forceinline__ void gemm_phase(PG8_LAS unsigned char* lds, const Gemm g, const Sched& S, const Epi& E) {
    int tid = threadIdx.x; asm volatile("" : "+v"(tid)); const int wid = __builtin_amdgcn_readfirstlane(tid >> 6), lane = tid & 63, wr = wid >> 2, wc = wid & 3, fr = lane & 15, fq = lane >> 4;
    const int K = g.K, nt = K / BK;
    unsigned voffA[2], voffB[2];
#pragma unroll
    for (int i = 0; i < 2; ++i) { int R, C; stage_rc(tid * 16 + i * 8192, R, C); const int Rb = Epi::PERM ? ((R & ~31) + perm32(R & 31)) : R;
        voffA[i] = (unsigned)(R * K + C) * 2u; voffB[i] = (unsigned)(Rb * K + C) * 2u; }
    const size_t kstep = (size_t)(BK * 2);
    const size_t hstep = (size_t)HALF * K * 2;
    const size_t tstep = 2 * hstep;
    const unsigned ldsw = (unsigned)wid * 1024u;
    const int aoff = lds_byte(wr * 64 + fr, fq * 8), boff = lds_byte(wc * 32 + fr, fq * 8);
#define PG8_SA(b, h) (((b) * 2 + (h)) * HTB)
#define PG8_SB(b, h) ((4 + (b) * 2 + (h)) * HTB)
#define PG8_STAGE(bufoff, gbase, voff) do { _Pragma("unroll") for (int _i = 0; _i < 2; ++_i) \
        __builtin_amdgcn_global_load_lds((const unsigned*)((const char*)(gbase) + (voff)[_i]), (PG8_LAS unsigned*)(lds + (bufoff) + ldsw + _i * 8192), 16, 0, 0); } while (0)
#define PG8_LDA(dst, b, h) do { _Pragma("unroll") for (int m = 0; m < 4; ++m) _Pragma("unroll") for (int k = 0; k < 2; ++k) dst[m][k] = *(const PG8_LAS bf16x8*)(lds + PG8_SA(b, h) + aoff + m * 2048 + k * 1024); } while (0)
#define PG8_LDB(dst, b, h) do { _Pragma("unroll") for (int n = 0; n < 2; ++n) _Pragma("unroll") for (int k = 0; k < 2; ++k) dst[n][k] = *(const PG8_LAS bf16x8*)(lds + PG8_SB(b, h) + boff + n * 2048 + k * 1024); } while (0)
#define PG8_MMA(ai, bj, At, Bt) do { __builtin_amdgcn_s_setprio(1); _Pragma("unroll") for (int m = 0; m < 4; ++m) _Pragma("unroll") for (int n = 0; n < 2; ++n) _Pragma("unroll") for (int k = 0; k < 2; ++k) \
        acc[ai][bj][m][n] = __builtin_amdgcn_mfma_f32_16x16x32_bf16(Bt[n][k], At[m][k], acc[ai][bj][m][n], 0, 0, 0); __builtin_amdgcn_s_setprio(0); } while (0)
#define PG8_WAIT_V(n) asm volatile("s_waitcnt vmcnt(" #n ")" ::: "memory")
#define PG8_WAIT_L(n) asm volatile("s_waitcnt lgkmcnt(" #n ")" ::: "memory")
#define PG8_BAR __builtin_amdgcn_s_barrier()
#define PG8_SCHED __builtin_amdgcn_sched_barrier(0)
    Unit cur, nxt; int ui = 0;
    if (!S.next(0, cur)) return;
    f32x4 acc[2][2][4][2];
#pragma unroll
    for (int a = 0; a < 2; ++a)
#pragma unroll
        for (int b = 0; b < 2; ++b)
#pragma unroll
            for (int m = 0; m < 4; ++m)
#pragma unroll
                for (int n = 0; n < 2; ++n) acc[a][b][m][n] = (f32x4){0.f, 0.f, 0.f, 0.f};
    bf16x8 At[4][2], B0[2][2], B1[2][2];
    const char* cA = (const char*)g.A + (size_t)cur.pm * tstep; const char* cB = (const char*)g.Bt + (size_t)cur.pn * tstep;
    S.a_ready(cur);
    if constexpr (SP2) {
        PG8_STAGE(PG8_SB(0, 0), cB, voffB); PG8_STAGE(PG8_SB(0, 1), cB + hstep, voffB); PG8_STAGE(PG8_SA(0, 0), cA, voffA); PG8_STAGE(PG8_SA(0, 1), cA + hstep, voffA);
        if (wr == 1) PG8_BAR;
        PG8_WAIT_V(2); PG8_BAR;
        PG8_STAGE(PG8_SB(1, 0), cB + kstep, voffB); PG8_STAGE(PG8_SA(1, 0), cA + kstep, voffA); PG8_STAGE(PG8_SB(1, 1), cB + hstep + kstep, voffB);
        PG8_WAIT_V(6); PG8_BAR;
    } else {
        PG8_STAGE(PG8_SB(0, 0), cB, voffB); PG8_STAGE(PG8_SA(0, 0), cA, voffA); PG8_STAGE(PG8_SB(0, 1), cB + hstep, voffB); PG8_STAGE(PG8_SA(0, 1), cA + hstep, voffA);
        if (wr == 1) PG8_BAR;
        PG8_WAIT_V(4); PG8_BAR;
        PG8_STAGE(PG8_SB(1, 0), cB + kstep, voffB); PG8_STAGE(PG8_SA(1, 0), cA + kstep, voffA); PG8_STAGE(PG8_SB(1, 1), cB + hstep + kstep, voffB);
        PG8_WAIT_V(6); PG8_BAR;
    }
    for (;;) {
        const bool has_next = S.next(ui + 1, nxt);
        const char* nA = has_next ? (const char*)g.A + (size_t)nxt.pm * tstep : cA; const char* nB = has_next ? (const char*)g.Bt + (size_t)nxt.pn * tstep : cB;
        for (int t = 0; t < nt; t += 2) {
            const bool last = (t == nt - 2);
            const char* a1 = cA + (size_t)(t + 1) * kstep;
            const char* a2 = last ? nA : cA + (size_t)(t + 2) * kstep; const char* b2 = last ? nB : cB + (size_t)(t + 2) * kstep;
            const char* a3 = a2 + kstep; const char* b3 = b2 + kstep;
            if (last && has_next) S.a_ready(nxt);
            if constexpr (SP2) {
            PG8_LDB(B0, 0, 0); PG8_LDB(B1, 0, 1); PG8_SCHED; PG8_LDA(At, 0, 0); PG8_STAGE(PG8_SA(1, 1), a1 + hstep, voffA);
            PG8_WAIT_V(8); PG8_WAIT_L(0); PG8_BAR; PG8_MMA(0, 0, At, B0); PG8_MMA(0, 1, At, B1); PG8_BAR; PG8_SCHED;
            PG8_LDA(At, 0, 1); PG8_STAGE(PG8_SB(0, 0), b2, voffB); PG8_STAGE(PG8_SB(0, 1), b2 + hstep, voffB); PG8_STAGE(PG8_SA(0, 0), a2, voffA);
            PG8_WAIT_V(8); PG8_WAIT_L(0); PG8_BAR; PG8_MMA(1, 0, At, B0); PG8_MMA(1, 1, At, B1); PG8_BAR; PG8_SCHED;
            PG8_LDB(B0, 1, 0); PG8_LDB(B1, 1, 1); PG8_SCHED; PG8_LDA(At, 1, 0); PG8_STAGE(PG8_SA(0, 1), a2 + hstep, voffA);
            PG8_WAIT_V(8); PG8_WAIT_L(0); PG8_BAR; PG8_MMA(0, 0, At, B0); PG8_MMA(0, 1, At, B1); PG8_BAR; PG8_SCHED;
            PG8_LDA(At, 1, 1); PG8_STAGE(PG8_SB(1, 0), b3, voffB); PG8_STAGE(PG8_SB(1, 1), b3 + hstep, voffB); PG8_STAGE(PG8_SA(1, 0), a3, voffA);
            PG8_WAIT_V(8); PG8_WAIT_L(0); PG8_BAR; PG8_MMA(1, 0, At, B0); PG8_MMA(1, 1, At, B1); PG8_BAR; PG8_SCHED;
            } else {
            PG8_LDB(B0, 0, 0); PG8_SCHED; PG8_LDA(At, 0, 0); PG8_STAGE(PG8_SA(1, 1), a1 + hstep, voffA);
            PG8_WAIT_L(8); PG8_BAR; PG8_WAIT_L(0); PG8_MMA(0, 0, At, B0); PG8_BAR; PG8_SCHED;
            PG8_LDB(B1, 0, 1); PG8_STAGE(PG8_SB(0, 0), b2, voffB);
            PG8_BAR; PG8_WAIT_L(0); PG8_MMA(0, 1, At, B1); PG8_BAR;
            PG8_LDA(At, 0, 1); PG8_STAGE(PG8_SA(0, 0), a2, voffA);
            PG8_BAR; PG8_WAIT_L(0); PG8_MMA(1, 0, At, B0); PG8_BAR; PG8_SCHED;
            PG8_STAGE(PG8_SB(0, 1), b2 + hstep, voffB);
            PG8_WAIT_V(6); PG8_BAR; PG8_MMA(1, 1, At, B1); PG8_BAR;
            PG8_LDB(B0, 1, 0); PG8_SCHED; PG8_LDA(At, 1, 0); PG8_STAGE(PG8_SA(0, 1), a2 + hstep, voffA);
            PG8_WAIT_L(8); PG8_BAR; PG8_WAIT_L(0); PG8_MMA(0, 0, At, B0); PG8_BAR; PG8_SCHED;
            PG8_LDB(B1, 1, 1); PG8_STAGE(PG8_SB(1, 0), b3, voffB);
            PG8_BAR; PG8_WAIT_L(0); PG8_MMA(0, 1, At, B1); PG8_BAR;
            PG8_LDA(At, 1, 1); PG8_STAGE(PG8_SA(1, 0), a3, voffA);
            PG8_BAR; PG8_WAIT_L(0); PG8_MMA(1, 0, At, B0); PG8_BAR; PG8_SCHED;
            PG8_STAGE(PG8_SB(1, 1), b3 + hstep, voffB);
            PG8_WAIT_V(6); PG8_BAR; PG8_MMA(1, 1, At, B1); PG8_BAR;
            }
        }
        if constexpr (ALIGN_EPI) { if (wr == 0) PG8_BAR; }
        if constexpr (!Epi::AFTER_DRAIN) { E(acc, cur, wr, wc, fr, fq); S.done(cur); }
        if (!has_next) break;
#pragma unroll
        for (int a = 0; a < 2; ++a)
#pragma unroll
            for (int b = 0; b < 2; ++b)
#pragma unroll
                for (int m = 0; m < 4; ++m)
#pragma unroll
                    for (int n = 0; n < 2; ++n) acc[a][b][m][n] = (f32x4){0.f, 0.f, 0.f, 0.f};
        cur = nxt; cA = nA; cB = nB; ++ui;
        if constexpr (ALIGN_EPI) { if (wr == 1) PG8_BAR; }
    }
    PG8_WAIT_V(0);
    if constexpr (!ALIGN_EPI) { if (wr == 0) PG8_BAR; }
    PG8_BAR;
    if constexpr (Epi::AFTER_DRAIN) { E.fused(acc, cur, wr, wc, fr, fq, lds, wid, lane); S.done(cur); }
#undef PG8_SA
#undef PG8_SB
#undef PG8_STAGE
#undef PG8_LDA
#undef PG8_LDB
#undef PG8_MMA
#undef PG8_WAIT_V
#undef PG8_WAIT_L
#undef PG8_BAR
#undef PG8_SCHED
}
}
#define DEVI __device__ __forceinline__
typedef unsigned short bf16;
typedef float f32x4 __attribute__((ext_vector_type(4)));
typedef short bf16x8 __attribute__((ext_vector_type(8)));
typedef unsigned u32x4 __attribute__((ext_vector_type(4)));
typedef unsigned u32x2 __attribute__((ext_vector_type(2)));

constexpr int NTOK = 12288, UP = 3584, LOP = 2560, FFP = 2816, HP = 3072;
constexpr size_t MiB = 1u << 20;
constexpr size_t WS_MOD = 0, WS_H3 = 1 * MiB, WS_WMIX = 3 * MiB, WS_WFFN = 15 * MiB, WS_HR = 32 * MiB, WS_A = 50 * MiB, WS_U = 74 * MiB,
                 WS_LO = 158 * MiB, WS_Y = 218 * MiB, WS_KV = 266 * MiB, WS_DEC = 314 * MiB, WS_CTL = 315 * MiB, WS_END = 316 * MiB;
constexpr size_t WS_VGT = WS_LO, WS_X0C = WS_LO + 24 * MiB, WS_YT = WS_Y, WS_X = WS_Y;
constexpr int OUT_SG = 12582912, OUT_SR = 14680064;
constexpr int LDS_BYTES = 139264, MISC_OFF = 135168;
constexpr float ALPHA_F = 1.6817928305074290f;
constexpr float INV2PI = 0.15915494309189535f;

struct Args { const float* in[42]; float* out; unsigned char* ws; int ph_lo, ph_hi; };
typedef const __attribute__((address_space(4))) Args* ArgsP;

DEVI float bflo(unsigned u) { return __uint_as_float(u << 16); }
DEVI float bfhi(unsigned u) { return __uint_as_float(u & 0xffff0000u); }
DEVI unsigned pk2(float lo, float hi) { return pg8::cvt_pk_bf16(lo, hi); }
DEVI float sigm(float x) { return 1.f / (1.f + __expf(-x)); }
DEVI float sin_rev(float rev) { rev -= rintf(rev); return __builtin_amdgcn_sinf(rev); }
DEVI float cos_rev(float rev) { rev -= rintf(rev); return __builtin_amdgcn_cosf(rev); }
DEVI float wave_sum(float v) {
#pragma unroll
    for (int o = 1; o < 64; o <<= 1) v += __shfl_xor(v, o);
    return v;
}
template <int CTRL> DEVI float dppf(float v) { return __int_as_float(__builtin_amdgcn_update_dpp(0, __float_as_int(v), CTRL, 0xf, 0xf, true)); }
DEVI float red8(float v) { v += dppf<0xB1>(v); v += dppf<0x4E>(v); v += dppf<0x141>(v); return v; }
DEVI float red16(float v) { v = red8(v); v += dppf<0x140>(v); return v; }
#define LDSW() asm volatile("s_waitcnt lgkmcnt(0)" ::: "memory")
DEVI void unpack8(const u32x4 w, float* f) { f[0] = bflo(w.x); f[1] = bfhi(w.x); f[2] = bflo(w.y); f[3] = bfhi(w.y); f[4] = bflo(w.z); f[5] = bfhi(w.z); f[6] = bflo(w.w); f[7] = bfhi(w.w); }
DEVI u32x4 pack8(const float* f) { u32x4 w; w.x = pk2(f[0], f[1]); w.y = pk2(f[2], f[3]); w.z = pk2(f[4], f[5]); w.w = pk2(f[6], f[7]); return w; }
DEVI f32x4 mfma16(bf16x8 bfr, bf16x8 afr, f32x4 c) { return __builtin_amdgcn_mfma_f32_16x16x32_bf16(bfr, afr, c, 0, 0, 0); }

DEVI void tokinfo(int tok, int& tok0, int& L) { if (tok < 4096) { tok0 = tok & ~255; L = 256; } else { tok0 = 4096 + ((tok - 4096) & ~2047); L = 2048; } }
DEVI int cond_of(int tok) { return tok < 4096 ? 0 : 1 + ((tok - 4096) >> 11); }

DEVI void tr_item(const float* W, int K, int N, bf16* WT, int row_off, int rmul, float* scr, int item, int lane) {
    const int nblk = N / 32, kb = item / nblk, nb = item % nblk, k0 = 64 * kb, n0 = 32 * nb;
#pragma unroll 8
    for (int i = 0; i < 32; ++i) { const int kk = 2 * i + (lane >> 5); scr[kk * 33 + (lane & 31)] = W[(size_t)(k0 + kk) * N + n0 + (lane & 31)]; }
    LDSW();
    const int c = lane & 7;
#pragma unroll
    for (int j = 0; j < 4; ++j) { const int n = (lane >> 3) + 8 * j; const float* s = scr + (8 * c) * 33 + n;
        u32x4 o; o.x = pk2(s[0 * 33], s[1 * 33]); o.y = pk2(s[2 * 33], s[3 * 33]); o.z = pk2(s[4 * 33], s[5 * 33]); o.w = pk2(s[6 * 33], s[7 * 33]);
        *(u32x4*)(WT + (size_t)(row_off + rmul * (n0 + n)) * K + k0 + 8 * c) = o; }
    LDSW();
}
DEVI void conv_job(const float* W, int K, int N, bf16* WT, int row_off, int rmul, float* scr, int gw, int NGW, int lane, int& rot) {
    const int nitems = (K / 64) * (N / 32); const int start = (gw - (rot % NGW) + NGW) % NGW;
    for (int it = start; it < nitems; it += NGW) tr_item(W, K, N, WT, row_off, rmul, scr, it, lane);
    rot += nitems;
}
DEVI void convert_mix(ArgsP a, int layer, float* scr, int gw, int NGW, int lane) {
    const int i = layer >> 1; int rot = 0;
    bf16* W0 = (bf16*)(a->ws + WS_WMIX); bf16* W1 = (bf16*)(a->ws + WS_WMIX + 7 * MiB); bf16* W2 = (bf16*)(a->ws + WS_WMIX + 9 * MiB);
    if ((layer & 1) == 0) {
        conv_job(a->in[13] + (size_t)i * 1024 * 3520, 1024, 3520, W0, 0, 1, scr, gw, NGW, lane, rot);
        conv_job(a->in[14] + (size_t)i * 1024 * 1024, 1024, 1024, W1, 0, 1, scr, gw, NGW, lane, rot);
        const int gt = gw * 64 + lane, NGT = NGW * 64;
        for (int u = gt; u < 64 * 1024 / 8; u += NGT) *(u32x4*)(W0 + (size_t)3520 * 1024 + (size_t)u * 8) = (u32x4){0u, 0u, 0u, 0u};
        const float* w2 = a->in[20] + (size_t)i * 2 * 64 * 512; const float* a2 = a->in[22] + (size_t)i * 2 * 64 * 512; const float* g2 = a->in[23] + (size_t)i * 160 * 512;
        for (int u = gt; u < 2560 * 64; u += NGT) {
            const int n = u >> 6, k8 = (u & 63) * 8, blk = n >> 9, c = n & 511; float f[8];
#pragma unroll
            for (int e = 0; e < 8; ++e) { const int k = k8 + e; float v = 0.f;
                if (blk < 2) { const int r = k - blk * 64; if (r >= 0 && r < 64) v = w2[(size_t)(blk * 64 + r) * 512 + c]; }
                else if (blk < 4) { const int r = k - 128 - (blk - 2) * 64; if (r >= 0 && r < 64) v = a2[(size_t)((blk - 2) * 64 + r) * 512 + c]; }
                else { const int r = k - 256; if (r >= 0 && r < 160) v = g2[(size_t)r * 512 + c]; }
                f[e] = v; }
            *(u32x4*)(W2 + (size_t)n * 512 + k8) = pack8(f);
        }
    } else {
        conv_job(a->in[29] + (size_t)i * 1024 * 3072, 1024, 3072, W0, 0, 1, scr, gw, NGW, lane, rot);
        conv_job(a->in[41] + (size_t)i * 1024 * 1024, 1024, 1024, W1, 0, 1, scr, gw, NGW, lane, rot);
    }
}
DEVI void convert_ffn(ArgsP a, int layer, float* scr, int gw, int NGW, int lane) {
    int rot = 0; bf16* WGU = (bf16*)(a->ws + WS_WFFN); bf16* WDN = (bf16*)(a->ws + WS_WFFN + 11 * MiB);
    conv_job(a->in[10] + (size_t)layer * 1024 * 2816, 1024, 2816, WGU, 0, 2, scr, gw, NGW, lane, rot);
    conv_job(a->in[11] + (size_t)layer * 1024 * 2816, 1024, 2816, WGU, 1, 2, scr, gw, NGW, lane, rot);
    conv_job(a->in[12] + (size_t)layer * 2816 * 1024, 2816, 1024, WDN, 0, 1, scr, gw, NGW, lane, rot);
}

DEVI void ln_mod_rows(ArgsP a, int mode, const float* lng, const float* lnb, const float* modsh, int gw, int NGW, int lane) {
    float* X = a->out; bf16* A = (bf16*)(a->ws + WS_A);
    for (int row = gw; row < NTOK; row += NGW) {
        f32x4 v[4];
        if (mode == 0) {
            const float* src = row < 4096 ? a->in[0] + (size_t)row * 1024 : a->in[1] + (size_t)(row - 4096) * 1024;
#pragma unroll
            for (int j = 0; j < 4; ++j) v[j] = ((const f32x4*)src)[lane + 64 * j];
            if (row >= 4096) { const int t = (row - 4096) & 2047; const float pr = (float)(t >> 6), pc = (float)(t & 63);
#pragma unroll
                for (int e = 0; e < 4; ++e) { const float om = exp2f(-(float)(4 * lane + e) * (13.287712379549449f / 256.f)) * INV2PI;
                    v[0][e] += sin_rev(pr * om); v[1][e] += cos_rev(pr * om); v[2][e] += sin_rev(pc * om); v[3][e] += cos_rev(pc * om); } }
        } else {
            const float* src = X + (size_t)row * 1024; float s = 0.f;
#pragma unroll
            for (int j = 0; j < 4; ++j) { v[j] = ((const f32x4*)src)[lane + 64 * j]; s += (v[j][0] + v[j][1]) + (v[j][2] + v[j][3]); }
            const float mean = wave_sum(s) * (1.f / 1024.f); float q = 0.f;
#pragma unroll
            for (int j = 0; j < 4; ++j) { v[j] = v[j] - mean; q += (v[j][0] * v[j][0] + v[j][1] * v[j][1]) + (v[j][2] * v[j][2] + v[j][3] * v[j][3]); }
            const float rstd = 1.f / sqrtf(wave_sum(q) * (1.f / 1024.f) + 1e-5f);
#pragma unroll
            for (int j = 0; j < 4; ++j) { const f32x4 g = ((const f32x4*)lng)[lane + 64 * j], b = ((const f32x4*)lnb)[lane + 64 * j]; v[j] = v[j] * rstd * g + b; }
        }
#pragma unroll
        for (int j = 0; j < 4; ++j) ((f32x4*)(X + (size_t)row * 1024))[lane + 64 * j] = v[j];
        if (modsh) { const float* sh = modsh + cond_of(row) * 6144; const float* sc = sh + 1024;
#pragma unroll
            for (int j = 0; j < 4; ++j) { const f32x4 s4 = ((const f32x4*)sh)[lane + 64 * j], c4 = ((const f32x4*)sc)[lane + 64 * j]; const f32x4 o = v[j] * (c4 + 1.f) + s4;
                u32x2 w; w.x = pk2(o[0], o[1]); w.y = pk2(o[2], o[3]); ((u32x2*)(A + (size_t)row * 1024))[lane + 64 * j] = w; } }
    }
}

DEVI void mods_phase(ArgsP a, float* S  , float* PART  , int bid, int nb, int tid) {
    float* MOD = (float*)(a->ws + WS_MOD);
    const int wave = tid >> 6, lane = tid & 63;
    for (int u = tid; u < 5 * 1024; u += 512) { const int j = u >> 10, d = u & 1023; const float c = j == 0 ? a->in[5][d] : a->in[4][(j - 1) * 1024 + d]; S[u] = c * sigm(c); }
    __syncthreads();
    for (int it = bid; it < 384; it += nb) {
        const int l = it / 96, e = (it % 96) * 64 + lane; const float* w = a->in[6] + (size_t)l * 1024 * 6144 + (size_t)(wave * 128) * 6144 + e;
        float acc[5] = {0.f, 0.f, 0.f, 0.f, 0.f};
#pragma unroll 16
        for (int d = 0; d < 128; ++d) { const float wv = w[(size_t)d * 6144];
#pragma unroll
            for (int j = 0; j < 5; ++j) acc[j] += S[j * 1024 + wave * 128 + d] * wv; }
#pragma unroll
        for (int j = 0; j < 5; ++j) PART[(wave * 5 + j) * 64 + lane] = acc[j];
        __syncthreads();
        if (tid < 320) { const int j = tid >> 6; float s = a->in[7][l * 6144 + e];
#pragma unroll
            for (int w8 = 0; w8 < 8; ++w8) s += PART[(w8 * 5 + j) * 64 + lane];
            MOD[(l * 5 + j) * 6144 + e] = s; }
        __syncthreads();
    }
}

DEVI float rdl(float v, int i) { return __int_as_float(__builtin_amdgcn_readlane(__float_as_int(v), i)); }
DEVI void hy_mlp_item(ArgsP a, int item, int lane) {
    const int hl = item / 144, g = item % 144, sel = g >= 16, tg = sel ? g - 16 : g, L = sel ? 2048 : 256;
    float* H3 = (float*)(a->ws + WS_H3) + (size_t)(hl * 2304 + (sel ? 256 : 0)) * 64;
    const float* w1 = a->in[32] + hl * 33 * 64 + lane; const float* w2 = a->in[34] + hl * 4096 + lane; const float* w3 = a->in[36] + hl * 4096 + lane;
    const float b1 = a->in[33][hl * 64 + lane], b2 = a->in[35][hl * 64 + lane], b3 = a->in[37][hl * 64 + lane];
    const float f0 = a->in[38][hl * 192 + lane] * INV2PI, f1 = a->in[38][hl * 192 + 64 + lane] * INV2PI, f2 = a->in[38][hl * 192 + 128 + lane] * INV2PI;
    float w1r[33], w2r[64], w3r[64];
#pragma unroll
    for (int i = 0; i < 33; ++i) w1r[i] = w1[i * 64];
#pragma unroll
    for (int i = 0; i < 64; ++i) { w2r[i] = w2[i * 64]; w3r[i] = w3[i * 64]; }
    const float fk = 1e-4f + (float)((lane - 1) & 15) * ((15.f - 1e-4f) / 15.f);
    for (int tt = 0; tt < 16; ++tt) {
        const int tau = tg * 16 + tt; const float rev = fk * (float)tau / (float)L;
        const float zk = lane == 0 ? (float)tau / (float)(L - 1) : (lane <= 16 ? cos_rev(rev) : (lane <= 32 ? -sin_rev(rev) : 0.f));
        float acc = b1;
#pragma unroll
        for (int i = 0; i < 33; ++i) acc += rdl(zk, i) * w1r[i];
        const float h1 = sin_rev(f0 * acc); acc = b2;
#pragma unroll
        for (int i = 0; i < 64; ++i) acc += rdl(h1, i) * w2r[i];
        const float h2 = sin_rev(f1 * acc); acc = b3;
#pragma unroll
        for (int i = 0; i < 64; ++i) acc += rdl(h2, i) * w3r[i];
        H3[(size_t)tau * 64 + lane] = sin_rev(f2 * acc);
    }
}
DEVI void hy_out_item(ArgsP a, int item, float* wl  , int lane) {
    const int cb = item & 31, it2 = item >> 5, hl = it2 / 36, r = it2 % 36, sel = r >= 4, tb = sel ? r - 4 : r, L = sel ? 2048 : 256, tau = tb * 64 + lane;
    const float* H3 = (const float*)(a->ws + WS_H3) + (size_t)(hl * 2304 + (sel ? 256 : 0) + tau) * 64;
    const float* w4 = a->in[39] + (size_t)hl * 64 * 2048 + cb * 64;
#pragma unroll 8
    for (int rr = 0; rr < 64; ++rr) wl[lane * 64 + rr] = w4[(size_t)rr * 2048 + lane];
    float h[64];
#pragma unroll
    for (int i = 0; i < 16; ++i) { const f32x4 t = ((const f32x4*)H3)[i]; h[4 * i] = t[0]; h[4 * i + 1] = t[1]; h[4 * i + 2] = t[2]; h[4 * i + 3] = t[3]; }
    LDSW();
    bf16* HR = (bf16*)(a->ws + WS_HR + (size_t)hl * 9 * MiB + (sel ? 1 * MiB : 0));
    const float t = (float)tau / (float)(L - 1);
    for (int cc = 0; cc < 64; ++cc) {
        float acc = 0.f;
#pragma unroll
        for (int i = 0; i < 16; ++i) { const f32x4 w = *(const f32x4*)(wl + cc * 64 + 4 * i); acc += h[4 * i] * w[0] + h[4 * i + 1] * w[1] + h[4 * i + 2] * w[2] + h[4 * i + 3] * w[3]; }
        const int c = cb * 64 + cc, dir = c >> 10, d = c & 1023;
        const float delta = 3.0701134573253945f + 12.280453829301578f * ((float)d * (1.f / 1023.f));
        float val = acc * __expf(-t * delta);
        int x;
        if (dir == 0) { x = L - tau; if (tau == 0) val += a->in[40][hl * 1024 + d]; }
        else { x = tau == 0 ? 0 : L + tau; if (tau == 0) val = 0.f; }
        HR[(size_t)d * (2 * L) + x] = (bf16)(pk2(val, 0.f) & 0xffffu);
    }
    LDSW();
}
DEVI void blkinfo(int blk, int& sq, int& nb, int& nch) { if (blk < 64) { sq = blk >> 2; nb = blk & 3; nch = 4; } else { sq = 16 + ((blk - 64) >> 5); nb = (blk - 64) & 31; nch = 32; } }
DEVI void gla_la(ArgsP a, int i, int blk, int h, int dir, float* LA, int tid) {
    const bf16* U = (const bf16*)(a->ws + WS_U);
    const int c = tid >> 3, kq = tid & 7, tok = blk * 64 + (dir ? 63 - c : c);
    const u32x4* lp = (const u32x4*)(U + (size_t)tok * UP + 1536 + dir * 16);
    float lr[16]; unpack8(lp[0], lr); unpack8(lp[1], lr + 8);
    const float* wd = a->in[15] + (size_t)((i * 2 + dir) * 16) * 256 + h * 64 + kq * 8; const float* bd = a->in[16] + (i * 2 + dir) * 256 + h * 64 + kq * 8;
#pragma unroll
    for (int e = 0; e < 8; ++e) { float acc = bd[e];
#pragma unroll
        for (int r = 0; r < 16; ++r) acc += lr[r] * wd[r * 256 + e];
        const float ls = fminf(acc, 0.f) - __logf(1.f + __expf(-fabsf(acc)));
        LA[c * 65 + kq * 8 + e] = ls * (1.f / 16.f); }
    __syncthreads();
    if (tid < 64) { float s = 0.f; for (int cc = 0; cc < 64; ++cc) { s += LA[cc * 65 + tid]; LA[cc * 65 + tid] = s; } }
    __syncthreads();
}
DEVI void gla_passA(ArgsP a, int i, unsigned char* lds, int bid, int nb_, int tid) {
    const bf16* U = (const bf16*)(a->ws + WS_U); float* KV = (float*)(a->ws + WS_KV); float* DEC = (float*)(a->ws + WS_DEC);
    float* LA = (float*)lds; bf16* VT = (bf16*)(lds + 16896); bf16* KOT = (bf16*)(lds + 16896 + 18432);
    const int wave = tid >> 6, lane = tid & 63, fr = lane & 15, fq = lane >> 4;
    for (int item = bid; item < 1536; item += nb_) {
        const int dir = item & 1, h = (item >> 1) & 3, blk = item >> 3;
        gla_la(a, i, blk, h, dir, LA, tid);
        { const int c = tid >> 3, part = tid & 7, tok = blk * 64 + (dir ? 63 - c : c);
          const bf16* vp = U + (size_t)tok * UP + 512 + h * 128 + part * 16; const u32x4 v0 = ((const u32x4*)vp)[0], v1 = ((const u32x4*)vp)[1];
          const unsigned vv[8] = {v0.x, v0.y, v0.z, v0.w, v1.x, v1.y, v1.z, v1.w};
#pragma unroll
          for (int e = 0; e < 8; ++e) { VT[(part * 16 + 2 * e) * 72 + c] = (bf16)(vv[e] & 0xffffu); VT[(part * 16 + 2 * e + 1) * 72 + c] = (bf16)(vv[e] >> 16); }
          float kf[8]; unpack8(*(const u32x4*)(U + (size_t)tok * UP + 256 + h * 64 + part * 8), kf);
#pragma unroll
          for (int e = 0; e < 8; ++e) { const int k = part * 8 + e; const float ko = kf[e] * __expf(LA[63 * 65 + k] - LA[c * 65 + k]); KOT[k * 72 + c] = (bf16)(pk2(ko, 0.f) & 0xffffu); }
          if (tid < 64) DEC[(size_t)item * 64 + tid] = __expf(LA[63 * 65 + tid]); }
        __syncthreads();
        f32x4 acc[4];
#pragma unroll
        for (int nt = 0; nt < 4; ++nt) acc[nt] = (f32x4){0.f, 0.f, 0.f, 0.f};
#pragma unroll
        for (int ks = 0; ks < 2; ++ks) { const bf16x8 af = *(const bf16x8*)(VT + (16 * wave + fr) * 72 + fq * 8 + ks * 32);
#pragma unroll
            for (int nt = 0; nt < 4; ++nt) { const bf16x8 bfr = *(const bf16x8*)(KOT + (16 * nt + fr) * 72 + fq * 8 + ks * 32); acc[nt] = mfma16(bfr, af, acc[nt]); } }
#pragma unroll
        for (int nt = 0; nt < 4; ++nt) *(f32x4*)(KV + (size_t)item * 8192 + (16 * wave + fr) * 64 + 16 * nt + 4 * fq) = acc[nt];
        __syncthreads();
    }
}
DEVI void gla_passB(ArgsP a, int i, int gt, int NGT) {
    float* KV = (float*)(a->ws + WS_KV); const float* DEC = (const float*)(a->ws + WS_DEC);
    for (int u = gt; u < 160 * 8192; u += NGT) {
        const int e = u & 8191, ch = u >> 13, dir = ch & 1, h = (ch >> 1) & 3, sq = ch >> 3, v = e >> 6, k = e & 63;
        const int nch = sq < 16 ? 4 : 32, blk0 = sq < 16 ? sq * 4 : 64 + (sq - 16) * 32;
        float S = 0.f;
        if (sq >= 16) S = a->in[2][(size_t)((((sq - 16) * 2 + i) * 2 + dir) * 4 + h) * 8192 + k * 128 + v];
        for (int n = 0; n < nch; ++n) { const int blk = blk0 + (dir ? nch - 1 - n : n); const size_t item = (size_t)((blk * 4 + h) * 2 + dir);
            const float kv = KV[item * 8192 + e]; KV[item * 8192 + e] = S; S = DEC[item * 64 + k] * S + kv; }
        if (sq < 16) a->out[OUT_SG + (size_t)(((sq * 2 + i) * 2 + dir) * 4 + h) * 8192 + k * 128 + v] = S;
    }
}
DEVI void gla_passC(ArgsP a, int i, unsigned char* lds, int bid, int nb_, int tid) {
    const bf16* U = (const bf16*)(a->ws + WS_U); const float* KV = (const float*)(a->ws + WS_KV); bf16* MO = (bf16*)(a->ws + WS_A);
    float* LA = (float*)lds; bf16* QIN = (bf16*)(lds + 16896); bf16* KIN = (bf16*)(lds + 26112); bf16* VT = (bf16*)(lds + 35328); bf16* ST = (bf16*)(lds + 53760);
    bf16* P = (bf16*)(lds + 72192); float* O = (float*)(lds + 81408);
    const int wave = tid >> 6, lane = tid & 63, fr = lane & 15, fq = lane >> 4;
    for (int item = bid; item < 768; item += nb_) {
        const int h = item & 3, blk = item >> 2;
        for (int dir = 0; dir < 2; ++dir) {
            gla_la(a, i, blk, h, dir, LA, tid);
            { const int c = tid >> 3, part = tid & 7, tok = blk * 64 + (dir ? 63 - c : c);
              float qf[8], kf[8]; unpack8(*(const u32x4*)(U + (size_t)tok * UP + h * 64 + part * 8), qf); unpack8(*(const u32x4*)(U + (size_t)tok * UP + 256 + h * 64 + part * 8), kf);
#pragma unroll
              for (int e = 0; e < 8; ++e) { const float cum = LA[c * 65 + part * 8 + e]; qf[e] = qf[e] * __expf(cum) * 0.125f; kf[e] = kf[e] * __expf(-cum); }
              *(u32x4*)(QIN + c * 72 + part * 8) = pack8(qf); *(u32x4*)(KIN + c * 72 + part * 8) = pack8(kf);
              const bf16* vp = U + (size_t)tok * UP + 512 + h * 128 + part * 16; const u32x4 v0 = ((const u32x4*)vp)[0], v1 = ((const u32x4*)vp)[1];
              const unsigned vv[8] = {v0.x, v0.y, v0.z, v0.w, v1.x, v1.y, v1.z, v1.w};
#pragma unroll
              for (int e = 0; e < 8; ++e) { VT[(part * 16 + 2 * e) * 72 + c] = (bf16)(vv[e] & 0xffffu); VT[(part * 16 + 2 * e + 1) * 72 + c] = (bf16)(vv[e] >> 16); }
              const int v = tid >> 2, kq = (tid & 3) * 16; const float* sp = KV + (size_t)((blk * 4 + h) * 2 + dir) * 8192 + v * 64 + kq;
              float sf[16];
#pragma unroll
              for (int e = 0; e < 4; ++e) { const f32x4 t = ((const f32x4*)sp)[e]; sf[4 * e] = t[0]; sf[4 * e + 1] = t[1]; sf[4 * e + 2] = t[2]; sf[4 * e + 3] = t[3]; }
              *(u32x4*)(ST + v * 72 + kq) = pack8(sf); *(u32x4*)(ST + v * 72 + kq + 8) = pack8(sf + 8); }
            __syncthreads();
#pragma unroll
            for (int tt = 0; tt < 2; ++tt) { const int tile = wave * 2 + tt, mt = tile >> 2, nt = tile & 3; f32x4 sc = (f32x4){0.f, 0.f, 0.f, 0.f};
#pragma unroll
                for (int ks = 0; ks < 2; ++ks) { const bf16x8 af = *(const bf16x8*)(QIN + (16 * mt + fr) * 72 + fq * 8 + ks * 32); const bf16x8 bfr = *(const bf16x8*)(KIN + (16 * nt + fr) * 72 + fq * 8 + ks * 32); sc = mfma16(bfr, af, sc); }
                const int c = 16 * mt + fr, s0 = 16 * nt + 4 * fq;
#pragma unroll
                for (int r = 0; r < 4; ++r) if (s0 + r > c) sc[r] = 0.f;
                u32x2 w; w.x = pk2(sc[0], sc[1]); w.y = pk2(sc[2], sc[3]); *(u32x2*)(P + c * 72 + s0) = w; }
            __syncthreads();
            { const int mt = wave >> 1, ntb = (wave & 1) * 4; f32x4 acc[4];
#pragma unroll
              for (int q = 0; q < 4; ++q) acc[q] = (f32x4){0.f, 0.f, 0.f, 0.f};
#pragma unroll
              for (int ks = 0; ks < 2; ++ks) { const bf16x8 af = *(const bf16x8*)(P + (16 * mt + fr) * 72 + fq * 8 + ks * 32);
#pragma unroll
                  for (int q = 0; q < 4; ++q) { const bf16x8 bfr = *(const bf16x8*)(VT + (16 * (ntb + q) + fr) * 72 + fq * 8 + ks * 32); acc[q] = mfma16(bfr, af, acc[q]); } }
#pragma unroll
              for (int ks = 0; ks < 2; ++ks) { const bf16x8 af = *(const bf16x8*)(QIN + (16 * mt + fr) * 72 + fq * 8 + ks * 32);
#pragma unroll
                  for (int q = 0; q < 4; ++q) { const bf16x8 bfr = *(const bf16x8*)(ST + (16 * (ntb + q) + fr) * 72 + fq * 8 + ks * 32); acc[q] = mfma16(bfr, af, acc[q]); } }
              const int c = 16 * mt + fr, row = dir ? 63 - c : c;
#pragma unroll
              for (int q = 0; q < 4; ++q) { f32x4* op = (f32x4*)(O + row * 132 + 16 * (ntb + q) + 4 * fq); if (dir == 0) *op = acc[q]; else *op = *op + acc[q]; } }
            __syncthreads();
        }
        for (int rr = 0; rr < 8; ++rr) { const int row = wave * 8 + rr, tok = blk * 64 + row;
            const float o0 = O[row * 132 + 2 * lane], o1 = O[row * 132 + 2 * lane + 1];
            const float ss = wave_sum(o0 * o0 + o1 * o1); const float sc = 1.f / sqrtf(ss * (1.f / 128.f) + 1e-5f);
            const float n0 = a->in[17][i * 128 + 2 * lane], n1 = a->in[17][i * 128 + 2 * lane + 1];
            const unsigned gg = *(const unsigned*)(U + (size_t)tok * UP + 1024 + h * 128 + 2 * lane); const float g0 = bflo(gg), g1 = bfhi(gg);
            *(unsigned*)(MO + (size_t)tok * 1024 + h * 128 + 2 * lane) = pk2(o0 * sc * n0 * g0 * sigm(g0), o1 * sc * n1 * g1 * sigm(g1)); }
        __syncthreads();
    }
}

DEVI void rwkv_xprep(ArgsP a, int i, int gw, int NGW, int lane) {
    const bf16* U = (const bf16*)(a->ws + WS_U); bf16* X = (bf16*)(a->ws + WS_X);
    const float* mu0 = a->in[18] + (size_t)(i * 2) * 1952 + 1536 + lane * 8; const float* mu1 = mu0 + 1952;
    for (int tok = gw; tok < NTOK; tok += NGW) {
        u32x4 o = (u32x4){0u, 0u, 0u, 0u};
        if (lane < 52) { int tok0, L; tokinfo(tok, tok0, L); const bf16* p = U + (size_t)tok * UP + 3104 + lane * 8;
            float x[8], xp[8], xn[8]; unpack8(*(const u32x4*)p, x);
            if (tok > tok0) unpack8(*(const u32x4*)(p - UP), xp); else { for (int e = 0; e < 8; ++e) xp[e] = 0.f; }
            if (tok < tok0 + L - 1) unpack8(*(const u32x4*)(p + UP), xn); else { for (int e = 0; e < 8; ++e) xn[e] = 0.f; }
#pragma unroll
            for (int e = 0; e < 8; ++e) { float s = x[e] + mu0[e] * (xp[e] - x[e]) + mu1[e] * (xn[e] - x[e]);
                if (lane < 16) s = 1.f - 2.f / (1.f + __expf(2.f * s)); else if (lane >= 32) s = sigm(s);
                x[e] = s; }
            o = pack8(x); }
        *(u32x4*)(X + (size_t)tok * 512 + lane * 8) = o;
    }
}
struct StageRegs { u32x2 r[3], k[3], v[3], wl, al; };
DEVI void st_load(StageRegs& R, const bf16* U, const bf16* LO, int tok, bool hp, bool hn, int cr, int dir) {
    const bf16* p = U + (size_t)tok * UP + 1568 + cr; const u32x2 z = (u32x2){0u, 0u};
    R.r[1] = *(const u32x2*)p; R.k[1] = *(const u32x2*)(p + 512); R.v[1] = *(const u32x2*)(p + 1024);
    if (hp) { R.r[0] = *(const u32x2*)(p - UP); R.k[0] = *(const u32x2*)(p - UP + 512); R.v[0] = *(const u32x2*)(p - UP + 1024); } else { R.r[0] = z; R.k[0] = z; R.v[0] = z; }
    if (hn) { R.r[2] = *(const u32x2*)(p + UP); R.k[2] = *(const u32x2*)(p + UP + 512); R.v[2] = *(const u32x2*)(p + UP + 1024); } else { R.r[2] = z; R.k[2] = z; R.v[2] = z; }
    const bf16* q = LO + (size_t)tok * LOP + dir * 512 + cr; R.wl = *(const u32x2*)q; R.al = *(const u32x2*)(q + 1024);
}
DEVI void un4(const u32x2 w, float* f) { f[0] = bflo(w.x); f[1] = bfhi(w.x); f[2] = bflo(w.y); f[3] = bfhi(w.y); }
typedef float f32x2 __attribute__((ext_vector_type(2)));
struct StepRegs { f32x4 kk[2], w[2], ka[2], kd[2], wr[2]; float vi; f32x2 c; };
constexpr int SCAN_BUF = 49408;
DEVI void ld_step(StepRegs& q, const float* B, int s, int jp, int row) {
    const float* p = B + s * 64 + 8 * jp;
#pragma unroll
    for (int e = 0; e < 2; ++e) { q.kk[e] = *(const f32x4*)(p + 4 * e); q.w[e] = *(const f32x4*)(p + 2048 + 4 * e); q.ka[e] = *(const f32x4*)(p + 4096 + 4 * e);
        q.kd[e] = *(const f32x4*)(p + 6144 + 4 * e); q.wr[e] = *(const f32x4*)(p + 8192 + 4 * e); }
    q.vi = B[10240 + s * 64 + row]; q.c = *(const f32x2*)(B + 12288 + 2 * s);
}
#define P2(v, e, h) ((f32x2){(v)[e][2 * (h)], (v)[e][2 * (h) + 1]})
DEVI void rwkv_scan_item(ArgsP a, int i, int item, unsigned char* lds, int tid) {
    const int half = item & 1, dir = (item >> 1) & 1, h = (item >> 2) & 7, sq = item >> 5;
    const int L = sq < 16 ? 256 : 2048, tok0 = sq < 16 ? sq * 256 : 4096 + (sq - 16) * 2048, nch = L / 32;
    const int wave = __builtin_amdgcn_readfirstlane(tid >> 6), lane = tid & 63;
    if (wave >= 4) {
        const bf16* U = (const bf16*)(a->ws + WS_U); const bf16* LO = (const bf16*)(a->ws + WS_LO);
        const int t2 = tid - 256, sb_ = t2 >> 4, jq = t2 & 15, cr = h * 64 + jq * 4;
        float m0r[4], m1r[4], m0k[4], m1k[4], m0v[4], m1v[4], w0[4], a0[4], kkc[4], kac[4];
        { const float* mu0 = a->in[18] + (size_t)(i * 2) * 1952 + cr; const float* mu1 = mu0 + 1952;
#pragma unroll
          for (int e = 0; e < 4; ++e) { m0r[e] = mu0[e]; m1r[e] = mu1[e]; m0k[e] = mu0[512 + e]; m1k[e] = mu1[512 + e]; m0v[e] = mu0[1024 + e]; m1v[e] = mu1[1024 + e];
              w0[e] = a->in[19][(i * 2 + dir) * 512 + cr + e]; a0[e] = a->in[21][(i * 2 + dir) * 512 + cr + e]; kkc[e] = a->in[24][i * 512 + cr + e]; kac[e] = a->in[25][i * 512 + cr + e]; } }
        for (int ch = 0; ch <= nch; ++ch) {
            if (ch < nch) {
                float* B_ = (float*)(lds + (ch & 1) * SCAN_BUF);
                StageRegs R[2];
#pragma unroll
                for (int q = 0; q < 2; ++q) { const int tt_ = ch * 32 + sb_ + 16 * q; const int tl_ = dir ? L - 1 - tt_ : tt_; st_load(R[q], U, LO, tok0 + tl_, tl_ > 0, tl_ < L - 1, cr, dir); }
#pragma unroll
                for (int q = 0; q < 2; ++q) { const int ss_ = sb_ + 16 * q;
                    float rc[4], rp[4], rn[4], kc[4], kp[4], kn[4], vc[4], vp[4], vn[4], wl[4], al[4];
                    un4(R[q].r[1], rc); un4(R[q].r[0], rp); un4(R[q].r[2], rn); un4(R[q].k[1], kc); un4(R[q].k[0], kp); un4(R[q].k[2], kn); un4(R[q].v[1], vc); un4(R[q].v[0], vp); un4(R[q].v[2], vn); un4(R[q].wl, wl); un4(R[q].al, al);
                    f32x4 o_kk, o_w, o_ka, o_kd, o_r, o_v; float kk_[4]; float ssq = 0.f;
#pragma unroll
                    for (int e = 0; e < 4; ++e) { const float rs = rc[e] + m0r[e] * (rp[e] - rc[e]) + m1r[e] * (rn[e] - rc[e]); const float ks = kc[e] + m0k[e] * (kp[e] - kc[e]) + m1k[e] * (kn[e] - kc[e]);
                        const float vs = vc[e] + m0v[e] * (vp[e] - vc[e]) + m1v[e] * (vn[e] - vc[e]); kk_[e] = ks * kkc[e]; ssq += kk_[e] * kk_[e];
                        const float av = sigm(a0[e] + al[e]); const float xw = -(w0[e] + wl[e]); const float sp = fmaxf(xw, 0.f) + __logf(1.f + __expf(-fabsf(xw)));
                        o_w[e] = __expf(-__expf(-sp - 0.5f)); o_r[e] = rs; o_v[e] = vs; o_kd[e] = ks * (1.f + (av - 1.f) * kac[e]); o_ka[e] = av; }
                    ssq = red16(ssq); const float inv = 1.f / fmaxf(sqrtf(ssq), 1e-12f); float c1_ = 0.f, c2_ = 0.f;
#pragma unroll
                    for (int e = 0; e < 4; ++e) { o_kk[e] = kk_[e] * inv; o_ka[e] = o_kk[e] * o_ka[e]; c1_ += o_ka[e] * o_r[e]; c2_ += o_kd[e] * o_r[e]; o_r[e] = o_r[e] * o_w[e]; }
                    c1_ = red16(c1_); c2_ = red16(c2_);
                    const int o_ = ss_ * 64 + jq * 4; *(f32x4*)(B_ + o_) = o_kk; *(f32x4*)(B_ + 2048 + o_) = o_w; *(f32x4*)(B_ + 4096 + o_) = o_ka; *(f32x4*)(B_ + 6144 + o_) = o_kd; *(f32x4*)(B_ + 8192 + o_) = o_r; *(f32x4*)(B_ + 10240 + o_) = o_v;
                    if (jq == 0) *(f32x2*)(B_ + 12288 + 2 * ss_) = (f32x2){c1_, c2_}; }
            }
            __syncthreads();
        }
    } else {
        float* Y = (float*)(a->ws + WS_Y) + (size_t)dir * NTOK * 512;
        const int row = half * 32 + wave * 8 + (lane >> 3), jp = lane & 7;
        f32x4 st[2] = {(f32x4){0.f, 0.f, 0.f, 0.f}, (f32x4){0.f, 0.f, 0.f, 0.f}};
        if (sq >= 16) { const float* sp = a->in[3] + (size_t)(((((sq - 16) * 2 + i) * 2 + dir) * 8 + h) * 64 + row) * 64 + 8 * jp; st[0] = *(const f32x4*)sp; st[1] = *(const f32x4*)(sp + 4); }
        __syncthreads();
        for (int ch = 0; ch < nch; ++ch) {
            const float* B = (const float*)(lds + (ch & 1) * SCAN_BUF);
            float* yp = Y + (size_t)(tok0 + (dir ? L - 1 - ch * 32 : ch * 32)) * 512 + h * 64 + row; const int ystep = dir ? -512 : 512;
            StepRegs cur, nxt; ld_step(cur, B, 0, jp, row);
#pragma unroll 2
            for (int s = 0; s < 32; ++s) {
                ld_step(nxt, B, s < 31 ? s + 1 : 31, jp, row);
                f32x2 q1 = P2(st, 0, 0) * P2(cur.kk, 0, 0), q2 = P2(st, 0, 0) * P2(cur.wr, 0, 0);
                q1 += P2(st, 0, 1) * P2(cur.kk, 0, 1); q2 += P2(st, 0, 1) * P2(cur.wr, 0, 1);
                q1 += P2(st, 1, 0) * P2(cur.kk, 1, 0); q2 += P2(st, 1, 0) * P2(cur.wr, 1, 0);
                q1 += P2(st, 1, 1) * P2(cur.kk, 1, 1); q2 += P2(st, 1, 1) * P2(cur.wr, 1, 1);
                float p1 = q1[0] + q1[1], p2 = q2[0] + q2[1];
                const f32x2 vv = (f32x2){cur.vi, cur.vi};
                f32x2 t[4];
#pragma unroll
                for (int e = 0; e < 4; ++e) t[e] = P2(st, e >> 1, e & 1) * P2(cur.w, e >> 1, e & 1) + vv * P2(cur.kd, e >> 1, e & 1);
                p1 += dppf<0xB1>(p1); p2 += dppf<0xB1>(p2); p1 += dppf<0x4E>(p1); p2 += dppf<0x4E>(p2); p1 += dppf<0x141>(p1); p2 += dppf<0x141>(p2);
                const float sa = -p1; const f32x2 sv = (f32x2){sa, sa};
#pragma unroll
                for (int e = 0; e < 4; ++e) t[e] = t[e] + sv * P2(cur.ka, e >> 1, e & 1);
                st[0] = (f32x4){t[0][0], t[0][1], t[1][0], t[1][1]}; st[1] = (f32x4){t[2][0], t[2][1], t[3][0], t[3][1]};
                const float y = p2 + sa * cur.c[0] + cur.vi * cur.c[1];
                if (jp == 0) yp[(ptrdiff_t)s * ystep] = y;
                cur = nxt;
            }
            __syncthreads();
        }
        if (sq < 16) { float* op = a->out + OUT_SR + (size_t)(((((sq * 2 + i) * 2 + dir) * 8 + h) * 64 + row) * 64) + 8 * jp; *(f32x4*)op = st[0]; *(f32x4*)(op + 4) = st[1]; }
    }
}
#undef P2
DEVI void rwkv_scan_phase(ArgsP a, int i, unsigned char* lds, int bid, int nb_, int tid, int rep) {
#ifdef SCAN_PROBE_LATENT_ONLY
    if (rep == 1 && bid >= 128) return;
#endif
#ifdef SCAN_PROBE_CTX_ONLY
    if (rep == 1 && bid < 128) return;
#endif
    if (nb_ == 256) { if (bid < 128) rwkv_scan_item(a, i, 512 + bid, lds, tid); else for (int q = 0; q < 4; ++q) rwkv_scan_item(a, i, (bid - 128) * 4 + q, lds, tid); }
    else for (int it = bid; it < 640; it += nb_) rwkv_scan_item(a, i, 639 - it, lds, tid);
}
DEVI void rwkv_post(ArgsP a, int i, int gw, int NGW, int lane) {
    const bf16* U = (const bf16*)(a->ws + WS_U); const bf16* LO = (const bf16*)(a->ws + WS_LO); const float* Y = (const float*)(a->ws + WS_Y); bf16* MO = (bf16*)(a->ws + WS_A);
    const int c8 = lane * 8; const float* mu0 = a->in[18] + (size_t)(i * 2) * 1952 + c8; const float* mu1 = mu0 + 1952;
    for (int tok = gw; tok < NTOK; tok += NGW) {
        int tok0, L; tokinfo(tok, tok0, L); const bool hp = tok > tok0, hn = tok < tok0 + L - 1;
        const bf16* p = U + (size_t)tok * UP + 1568 + c8; float sh[3][8];
#pragma unroll
        for (int m = 0; m < 3; ++m) { float x[8], xp[8], xn[8]; unpack8(*(const u32x4*)(p + m * 512), x);
            if (hp) unpack8(*(const u32x4*)(p + m * 512 - UP), xp); else { for (int e = 0; e < 8; ++e) xp[e] = 0.f; }
            if (hn) unpack8(*(const u32x4*)(p + m * 512 + UP), xn); else { for (int e = 0; e < 8; ++e) xn[e] = 0.f; }
#pragma unroll
            for (int e = 0; e < 8; ++e) sh[m][e] = x[e] + mu0[m * 512 + e] * (xp[e] - x[e]) + mu1[m * 512 + e] * (xn[e] - x[e]); }
        float y[8]; { const f32x4 a0 = *(const f32x4*)(Y + (size_t)tok * 512 + c8), a1 = *(const f32x4*)(Y + (size_t)tok * 512 + c8 + 4);
            const f32x4 b0 = *(const f32x4*)(Y + (size_t)(NTOK + tok) * 512 + c8), b1 = *(const f32x4*)(Y + (size_t)(NTOK + tok) * 512 + c8 + 4);
#pragma unroll
            for (int e = 0; e < 4; ++e) { y[e] = a0[e] + b0[e]; y[4 + e] = a1[e] + b1[e]; } }
        float s = 0.f, bon = 0.f;
#pragma unroll
        for (int e = 0; e < 8; ++e) { s += y[e]; bon += sh[0][e] * sh[1][e] * a->in[26][i * 512 + c8 + e]; }
        const float mean = red8(s) * (1.f / 64.f); bon = red8(bon); float q = 0.f;
#pragma unroll
        for (int e = 0; e < 8; ++e) { y[e] -= mean; q += y[e] * y[e]; }
        const float rs = 1.f / sqrtf(red8(q) * (1.f / 64.f) + 64e-5f);
        float g[8]; unpack8(*(const u32x4*)(LO + (size_t)tok * LOP + 2048 + c8), g);
#pragma unroll
        for (int e = 0; e < 8; ++e) y[e] = (y[e] * rs * a->in[27][i * 512 + c8 + e] + a->in[28][i * 512 + c8 + e] + bon * sh[2][e]) * g[e];
        *(u32x4*)(MO + (size_t)tok * 1024 + 512 + c8) = pack8(y);
    }
}

DEVI void hy_conv_phase(ArgsP a, int hl, unsigned char* lds, int bid, int nb_, int tid) {
    const bf16* U = (const bf16*)(a->ws + WS_U); bf16* VGT = (bf16*)(a->ws + WS_VGT); bf16* X0C = (bf16*)(a->ws + WS_X0C); bf16* T = (bf16*)lds;
    const float* cw = a->in[30] + (size_t)hl * 3 * 3072; const float* cb = a->in[31] + (size_t)hl * 3072;
    for (int item = bid; item < 192 * 16; item += nb_) {
        const int dblk = item & 15, blk = item >> 4;
        { const int t = tid >> 3, dg = tid & 7, tok = blk * 64 + t; int tok0, L; tokinfo(tok, tok0, L); const bool hp = tok > tok0, hn = tok < tok0 + L - 1;
          float cv[3][8];
#pragma unroll
          for (int m = 0; m < 3; ++m) { const int col = m * 1024 + dblk * 64 + dg * 8; const bf16* p = U + (size_t)tok * HP + col; float x[8], xp[8], xn[8]; unpack8(*(const u32x4*)p, x);
              if (hp) unpack8(*(const u32x4*)(p - HP), xp); else { for (int e = 0; e < 8; ++e) xp[e] = 0.f; }
              if (hn) unpack8(*(const u32x4*)(p + HP), xn); else { for (int e = 0; e < 8; ++e) xn[e] = 0.f; }
#pragma unroll
              for (int e = 0; e < 8; ++e) cv[m][e] = xp[e] * cw[col + e] + x[e] * cw[3072 + col + e] + xn[e] * cw[6144 + col + e] + cb[col + e]; }
          *(u32x4*)(X0C + (size_t)tok * 1024 + dblk * 64 + dg * 8) = pack8(cv[0]);
#pragma unroll
          for (int e = 0; e < 8; ++e) T[(dg * 8 + e) * 72 + t] = (bf16)(pk2(cv[2][e] * cv[1][e], 0.f) & 0xffffu); }
        __syncthreads();
        { const int dd = tid >> 3, tq = tid & 7; *(u32x4*)(VGT + (size_t)(dblk * 64 + dd) * NTOK + blk * 64 + tq * 8) = *(const u32x4*)(T + dd * 72 + tq * 8); }
        __syncthreads();
    }
}
template <int L, int NBAT>
DEVI void toeplitz_group(const bf16* HRrow, const bf16* VGTd, bf16* YTd, int tokbase, unsigned char* lds, int tid) {
    constexpr int NB1 = L / 64, M = NB1 * NBAT, MT = M / 16, NTW = 4 * MT / 8, CPS = 2 * L + 8, NG = 2 * L / 8 + 1;
    bf16* HRAW = (bf16*)lds; bf16* CP = (bf16*)(lds + 8192 + 16); bf16* VL = (bf16*)(lds + 8192 + 16 + 8 * (2 * 2048 + 8) * 2);
    const int wave = tid >> 6, lane = tid & 63, fr = lane & 15, fq = lane >> 4;
    for (int u = tid; u < 2 * L / 8; u += 512) *(u32x4*)(HRAW + u * 8) = *(const u32x4*)(HRrow + u * 8);
    for (int u = tid; u < NBAT * L / 8; u += 512) *(u32x4*)(VL + u * 8) = *(const u32x4*)(VGTd + tokbase + u * 8);
    __syncthreads();
    for (int g = tid; g < 8 * NG; g += 512) { const int c = g / NG, gi = g % NG; unsigned w[4];
#pragma unroll
        for (int e = 0; e < 4; ++e) { const int i0 = gi * 8 + c + 2 * e, i1 = i0 + 1; const unsigned lo = i0 < 2 * L ? HRAW[i0] : 0u, hi = i1 < 2 * L ? HRAW[i1] : 0u; w[e] = lo | (hi << 16); }
        *(u32x4*)(CP + c * CPS + gi * 8) = (u32x4){w[0], w[1], w[2], w[3]}; }
    __syncthreads();
    const int mt = wave % MT, nt0 = (wave / MT) * NTW, m = mt * 16 + fr, t1 = m / NBAT, b = m % NBAT;
    const int t1lo = (mt * 16) / NBAT, t1hi = (mt * 16 + 15) / NBAT;
    f32x4 acc[NTW];
#pragma unroll
    for (int q = 0; q < NTW; ++q) acc[q] = (f32x4){0.f, 0.f, 0.f, 0.f};
    for (int delta = t1lo - (NB1 - 1); delta <= t1hi; ++delta) {
        const int s1 = t1 - delta; const bool valid = s1 >= 0 && s1 < NB1;
#pragma unroll
        for (int ks = 0; ks < 2; ++ks) { const int k0 = ks * 32 + fq * 8;
            bf16x8 af = (bf16x8){0, 0, 0, 0, 0, 0, 0, 0}; if (valid) af = *(const bf16x8*)(VL + b * L + s1 * 64 + k0);
#pragma unroll
            for (int q = 0; q < NTW; ++q) { const int n = (nt0 + q) * 16 + fr; const int qq = k0 - n - 64 * delta + L; const int c = qq & 7;
                const bf16x8 bfr = *(const bf16x8*)(CP + c * CPS + (qq - c)); acc[q] = mfma16(bfr, af, acc[q]); } }
    }
#pragma unroll
    for (int q = 0; q < NTW; ++q) { u32x2 w; w.x = pk2(acc[q][0], acc[q][1]); w.y = pk2(acc[q][2], acc[q][3]);
        *(u32x2*)(YTd + tokbase + b * L + t1 * 64 + (nt0 + q) * 16 + 4 * fq) = w; }
    __syncthreads();
}
DEVI void hy_toeplitz_phase(ArgsP a, int hl, unsigned char* lds, int bid, int nb_, int tid) {
    const bf16* VGT = (const bf16*)(a->ws + WS_VGT); bf16* YT = (bf16*)(a->ws + WS_YT);
    const bf16* HR0 = (const bf16*)(a->ws + WS_HR + (size_t)hl * 9 * MiB); const bf16* HR1 = (const bf16*)(a->ws + WS_HR + (size_t)hl * 9 * MiB + 1 * MiB);
    for (int d = bid; d < 1024; d += nb_) {
        toeplitz_group<2048, 4>(HR1 + (size_t)d * 4096, VGT + (size_t)d * NTOK, YT + (size_t)d * NTOK, 4096, lds, tid);
        toeplitz_group<256, 16>(HR0 + (size_t)d * 512, VGT + (size_t)d * NTOK, YT + (size_t)d * NTOK, 0, lds, tid);
    }
}
DEVI void hy_back_phase(ArgsP a, unsigned char* lds, int bid, int nb_, int tid) {
    const bf16* YT = (const bf16*)(a->ws + WS_YT); const bf16* X0C = (const bf16*)(a->ws + WS_X0C); bf16* A2 = (bf16*)(a->ws + WS_A); bf16* T = (bf16*)lds;
    for (int item = bid; item < 192 * 16; item += nb_) {
        const int dblk = item & 15, blk = item >> 4;
        { const int dd = tid >> 3, tq = tid & 7; const u32x4 w = *(const u32x4*)(YT + (size_t)(dblk * 64 + dd) * NTOK + blk * 64 + tq * 8); const unsigned ww[4] = {w.x, w.y, w.z, w.w};
#pragma unroll
          for (int e = 0; e < 4; ++e) { T[(tq * 8 + 2 * e) * 72 + dd] = (bf16)(ww[e] & 0xffffu); T[(tq * 8 + 2 * e + 1) * 72 + dd] = (bf16)(ww[e] >> 16); } }
        __syncthreads();
        { const int t = tid >> 3, dg = tid & 7, tok = blk * 64 + t; float y[8], x0[8]; unpack8(*(const u32x4*)(T + t * 72 + dg * 8), y); unpack8(*(const u32x4*)(X0C + (size_t)tok * 1024 + dblk * 64 + dg * 8), x0);
#pragma unroll
          for (int e = 0; e < 8; ++e) y[e] *= x0[e];
          *(u32x4*)(A2 + (size_t)tok * 1024 + dblk * 64 + dg * 8) = pack8(y); }
        __syncthreads();
    }
}
#ifndef MK_ONE_LAUNCH
#define MK_ONE_LAUNCH 1
#endif
#ifndef PHMASK
#define PHMASK 0xFFFFu
#endif
#define PHON(k) ((PHMASK >> (k)) & 1u)
#ifndef DUPMASK
#define DUPMASK 0u
#endif
constexpr int N_PHASES = 42;
typedef pg8::bf16_t gb16;

#define LAS __attribute__((address_space(3)))
#define XB_TMO      128
#define XB_XCNT(j)  (256  + 64 * (j))
#define XB_XSUB(j)  (1280 + 64 * (j))
#define XB_XGEN(j)  (2304 + 64 * (j))
#define XB_TOP      3328
#define XB_TOPGEN   3392
#define XCD_BAR_WORDS 3456
#define XB_SPIN_CAP (1u << 18)

__device__ __forceinline__ unsigned xb_ld(unsigned* p)              { return __hip_atomic_load(p, __ATOMIC_RELAXED, __HIP_MEMORY_SCOPE_AGENT); }
__device__ __forceinline__ unsigned xb_add(unsigned* p, unsigned v) { return __hip_atomic_fetch_add(p, v, __ATOMIC_RELAXED, __HIP_MEMORY_SCOPE_AGENT); }
__device__ __forceinline__ unsigned xb_xcc_id() { return (unsigned)__builtin_amdgcn_s_getreg((3 << 11) | 20) & 0xFu; }
#define XB_SPIN(cond, bar) do { unsigned _sp = 0; while (cond) { __builtin_amdgcn_s_sleep(1); \
    if ((++_sp & 255u) == 0u) { if (xb_ld(&(bar)[XB_TMO])) break; if (_sp > XB_SPIN_CAP) { atomicAdd(&(bar)[XB_TMO], 1u); break; } } } } while (0)

struct XcdBarrier {
    unsigned* bar; unsigned x;
    volatile LAS unsigned* st;
};

__device__ __forceinline__ XcdBarrier xcd_barrier_post(unsigned* bar, volatile LAS unsigned* st) {
    XcdBarrier b; b.bar = bar; b.x = xb_xcc_id(); b.st = st;
    if (threadIdx.x == 0) (void)xb_add(&bar[XB_XCNT(b.x)], 1u);
    return b;
}
__device__ __forceinline__ void xcd_barrier_complete(unsigned* bar, unsigned x, unsigned& nloc, unsigned& nx) {
    const unsigned G = gridDim.x * gridDim.y * gridDim.z;
    unsigned sum, cnt, mine, sp = 0u;
    for (;;) {
        sum = 0u; cnt = 0u; mine = 0u;
#pragma unroll
        for (unsigned j = 0; j < 16; ++j) { const unsigned c = xb_ld(&bar[XB_XCNT(j)]); sum += c; cnt += (c > 0u) ? 1u : 0u; mine = (j == x) ? c : mine; }
        if (sum == G) break;
        __builtin_amdgcn_s_sleep(1);
        if ((++sp & 255u) == 0u) { if (xb_ld(&bar[XB_TMO])) break; if (sp > XB_SPIN_CAP) { atomicAdd(&bar[XB_TMO], 1u); break; } }
    }
    nloc = mine > 0u ? mine : 1u; nx = cnt > 0u ? cnt : 1u;
}

__device__ __forceinline__ void xcd_barrier(const XcdBarrier& b) {
    asm volatile("s_waitcnt vmcnt(0)" ::: "memory");
    __syncthreads();
    if (threadIdx.x == 0) {
        unsigned* bar = b.bar;
        __builtin_amdgcn_s_waitcnt(0);
        unsigned nloc = b.st[0], nx = b.st[1];
        if (nloc == 0u) { xcd_barrier_complete(bar, b.x, nloc, nx); b.st[0] = nloc; b.st[1] = nx; }
        const unsigned old = xb_add(&bar[XB_XSUB(b.x)], 1u);
        const unsigned gen = old / nloc;
        if (old + 1u == (gen + 1u) * nloc) {
            __builtin_amdgcn_fence(__ATOMIC_RELEASE, "agent");
            asm volatile("s_waitcnt vmcnt(0)" ::: "memory");
            const unsigned og = xb_add(&bar[XB_TOP], 1u);
            const unsigned tg = og / nx;
            if (og + 1u == (tg + 1u) * nx) xb_add(&bar[XB_TOPGEN], 1u);
            else XB_SPIN(xb_ld(&bar[XB_TOPGEN]) == tg, bar);
            __builtin_amdgcn_fence(__ATOMIC_ACQUIRE, "agent");
            xb_add(&bar[XB_XGEN(b.x)], 1u);
            asm volatile("s_waitcnt vmcnt(0)" ::: "memory");
        } else {
            XB_SPIN(xb_ld(&bar[XB_XGEN(b.x)]) == gen, bar);
            __builtin_amdgcn_fence(__ATOMIC_ACQUIRE, "agent");
            asm volatile("s_waitcnt vmcnt(0)" ::: "memory");
        }
    }
    __syncthreads();
}
template <class Epi>
DEVI void run_gemm(unsigned char* lds, const void* A, const void* Bt, int N, int K, const Epi& E) {
    int bid_ = blockIdx.x, nb_ = gridDim.x; asm volatile("" : "+s"(bid_), "+s"(nb_));
    pg8::Gemm g{(const gb16*)A, (const gb16*)Bt, NTOK, N, K}; pg8::StaticOrder S; S.init(NTOK, N, nb_, bid_);
    pg8::gemm_phase<Epi, pg8::StaticOrder, true, true>((PG8_LAS unsigned char*)lds, g, S, E);
}

__global__ void __launch_bounds__(512, 2) mk(const Args a0) {
    extern __shared__ __attribute__((aligned(16))) unsigned char lds[];
    const int ph_lo = ((ArgsP)__builtin_amdgcn_kernarg_segment_ptr())->ph_lo, ph_hi = ((ArgsP)__builtin_amdgcn_kernarg_segment_ptr())->ph_hi;
    XcdBarrier xbar; xbar.bar = nullptr; xbar.x = 0; xbar.st = nullptr;
    if (ph_hi - ph_lo > 1) {
        unsigned* barw = (unsigned*)(((ArgsP)__builtin_amdgcn_kernarg_segment_ptr())->ws + WS_CTL);
        volatile LAS unsigned* st = (volatile LAS unsigned*)((LAS unsigned char*)lds + MISC_OFF);
        if (threadIdx.x < 2) st[threadIdx.x] = 0u;
        if (blockIdx.x == 0) for (int u = threadIdx.x; u < XCD_BAR_WORDS; u += 512) __hip_atomic_store(barw + u, 0u, __ATOMIC_RELAXED, __HIP_MEMORY_SCOPE_AGENT);
        __threadfence();
        cg::this_grid().sync();
        xbar = xcd_barrier_post(barw, st);
    }
    int ph = ph_lo, rep = 0;
#pragma clang loop unroll(disable)
    while (ph < ph_hi) {
#define LA_ ArgsP a = (ArgsP)__builtin_amdgcn_kernarg_segment_ptr(); asm volatile("" : "+s"(a)); unsigned char* ws = a->ws; float* MOD = (float*)(ws + WS_MOD); (void)MOD
        int tid = threadIdx.x; asm volatile("" : "+v"(tid));
        const int lane = tid & 63, wave = __builtin_amdgcn_readfirstlane(tid >> 6);
        int bid = blockIdx.x, nb = gridDim.x; asm volatile("" : "+s"(bid), "+s"(nb));
        const int gw = bid * 8 + wave, NGW = nb * 8, gt = bid * 512 + tid, NGT = nb * 512;
        float* wscr = (float*)(lds + wave * 16384);
        int pbit = ph < 2 ? ph : ((ph - 2) % 10 == 0 ? 2 : (ph - 2) % 10 <= 3 ? 1 + 2 * ((ph - 2) % 10) + (((ph - 2) / 10) & 1) : 5 + (ph - 2) % 10);
        const int nrep = ((DUPMASK >> pbit) & 1u) ? 2 : 1;
        if (ph == 0) { if (PHON(0)) { LA_;
#ifndef P0DUP
#define P0DUP 0
#endif
            mods_phase(a, (float*)lds, (float*)(lds + 20480), bid, nb, tid);
            for (int it = NGW - 1 - gw; it < 288; it += NGW) hy_mlp_item(a, it, lane);
            convert_mix(a, 0, wscr, gw, NGW, lane);
            convert_ffn(a, 0, wscr, gw, NGW, lane); }
        } else if (ph == 1) { if (PHON(1)) { LA_;
            ln_mod_rows(a, 0, nullptr, nullptr, MOD, gw, NGW, lane);
            for (int it = gw; it < 72 * 32; it += NGW) hy_out_item(a, it, wscr, lane); }
        } else {
            const int l = (ph - 2) / 10, s = (ph - 2) % 10, i = l >> 1; const bool even = (l & 1) == 0;
            if (s == 0) { if (PHON(2)) { LA_;
                const int npad = even ? UP : HP;
                run_gemm(lds, ws + WS_A, ws + WS_WMIX, npad, 1024, pg8::EpiStoreBf16{(gb16*)(ws + WS_U), npad}); }
            } else if (s == 1) {
                if (even) { if (PHON(3)) { LA_; rwkv_xprep(a, i, gw, NGW, lane); gla_passA(a, i, lds, bid, nb, tid); } }
                else { if (PHON(4)) { LA_; hy_conv_phase(a, i, lds, bid, nb, tid); } }
            } else if (s == 2) {
                if (even) { if (PHON(5)) { LA_; gla_passB(a, i, gt, NGT); __syncthreads(); run_gemm(lds, ws + WS_X, ws + WS_WMIX + 9 * MiB, 2560, 512, pg8::EpiStoreBf16{(gb16*)(ws + WS_LO), LOP}); } }
                else { if (PHON(6)) { LA_; hy_toeplitz_phase(a, i, lds, bid, nb, tid); } }
            } else if (s == 3) {
                if (even) { if (PHON(7)) { LA_; rwkv_scan_phase(a, i, lds, bid, nb, tid, rep); } }
                else { if (PHON(8)) { LA_; hy_back_phase(a, lds, bid, nb, tid); } }
            } else if (s == 4) {
                if (even && PHON(9)) { LA_; gla_passC(a, i, lds, bid, nb, tid); rwkv_post(a, i, gw, NGW, lane); }
            } else if (s == 5) {
                if (PHON(10)) { LA_; run_gemm(lds, ws + WS_A, ws + WS_WMIX + 7 * MiB, 1024, 1024, pg8::EpiRes{a->out, MOD + (size_t)l * 5 * 6144 + 2048, ALPHA_F}); }
            } else if (s == 6) { if (PHON(11)) { LA_; const float* modl = MOD + (size_t)l * 5 * 6144;
                ln_mod_rows(a, 1, a->in[8] + (size_t)(l * 2) * 1024, a->in[9] + (size_t)(l * 2) * 1024, modl + 3072, gw, NGW, lane);
                if (l < 3) convert_mix(a, l + 1, wscr, gw, NGW, lane); }
            } else if (s == 7) {
                if (PHON(12)) { LA_; run_gemm(lds, ws + WS_A, ws + WS_WFFN, 5632, 1024, pg8::EpiSwiGLU{(gb16*)(ws + WS_U), FFP}); }
            } else if (s == 8) {
                if (PHON(13)) { LA_; run_gemm(lds, ws + WS_U, ws + WS_WFFN + 11 * MiB, 1024, 2816, pg8::EpiRes{a->out, MOD + (size_t)l * 5 * 6144 + 5120, ALPHA_F}); }
            } else { if (PHON(14)) { LA_;
                ln_mod_rows(a, 1, a->in[8] + (size_t)(l * 2 + 1) * 1024, a->in[9] + (size_t)(l * 2 + 1) * 1024, l < 3 ? MOD + (size_t)(l + 1) * 5 * 6144 : nullptr, gw, NGW, lane);
                if (l < 3) convert_ffn(a, l + 1, wscr, gw, NGW, lane); }
            }
        }
        if (++rep >= nrep) { rep = 0; ++ph; }
        if (ph < ph_hi) xcd_barrier(xbar);
    }
}

extern "C" void kernel_launch(void* const* d_in, const int* in_sizes, int n_in, void* d_out, int out_size, void* d_ws, size_t ws_size, hipStream_t stream) {
    static int grid = 0;
    if (grid == 0) {
        if (n_in != 42 || ws_size < WS_END) { fprintf(stderr, "kernel_launch: unexpected n_in %d / ws %zu\n", n_in, ws_size); grid = -1; return; }
        int dev = 0, cus = 0, per_cu = 0;
        hipGetDevice(&dev); hipDeviceGetAttribute(&cus, hipDeviceAttributeMultiprocessorCount, dev);
        if (hipFuncSetAttribute((const void*)mk, hipFuncAttributeMaxDynamicSharedMemorySize, LDS_BYTES) != hipSuccess) { fprintf(stderr, "kernel_launch: hipFuncSetAttribute failed\n"); grid = -1; return; }
        hipOccupancyMaxActiveBlocksPerMultiprocessor(&per_cu, (const void*)mk, 512, LDS_BYTES);
        (void)hipGetLastError();
        if (per_cu < 1) per_cu = 1;
        grid = cus * 1;
        fprintf(stderr, "kernel_launch: cus %d per_cu %d grid %d\n", cus, per_cu, grid);
    }
    if (grid < 0) return;
    Args a{};
    for (int k = 0; k < 42; ++k) a.in[k] = (const float*)d_in[k];
    a.out = (float*)d_out; a.ws = (unsigned char*)d_ws;
#if MK_ONE_LAUNCH
    a.ph_lo = 0; a.ph_hi = N_PHASES;
    void* args[] = {&a};
    hipError_t e = hipLaunchCooperativeKernel((const void*)mk, dim3(grid), dim3(512), args, LDS_BYTES, stream);
    if (e != hipSuccess) fprintf(stderr, "cooperative launch failed: %s (grid %d)\n", hipGetErrorString(e), grid);
#else
    for (int ph = 0; ph < N_PHASES; ++ph) {
        if (ph >= 2 && ((ph - 2) / 10) % 2 == 1 && (ph - 2) % 10 == 4) continue;
        a.ph_lo = ph; a.ph_hi = ph + 1;
        hipLaunchKernelGGL(mk, dim3(grid), dim3(512), LDS_BYTES, stream, a);
    }
#endif
}
```
